# Optimizing an MI355X kernel written in HIP

```python
import jax, jax.numpy as jnp
from jax import lax
import numpy as np

D_MODEL = 2048
BATCH = 2
SEQ = 8192
DEPTH = 2

N_META = 16
ATTN_HEADS = 8
ATTN_D = 64
ATTN_QK_WIDTH = ATTN_HEADS * 2 * ATTN_D
ATTN_WIDTH = ATTN_HEADS * 2 * ATTN_D
POOL_WINDOWS = (2, 4, 8, 16)
POOL_GROUPS = 4
POOL_WIDTH = 1024
POOL_GROUP_DIM = POOL_WIDTH // POOL_GROUPS
CONV_WIDTH = 1024
CONV_K = 3
N_BRANCH = 3
D_FF = 4 * D_MODEL
Q_BLOCK = 128
LN_EPS = 1e-5
RMS_EPS = 1e-5
NEG_INF = -1e30
DEEPNORM_ALPHA = (2 * DEPTH) ** 0.25
DEEPNORM_BETA = (8 * DEPTH) ** -0.25

IN_SIZES = (ATTN_QK_WIDTH, ATTN_QK_WIDTH, ATTN_WIDTH, POOL_WIDTH,
            CONV_WIDTH, CONV_WIDTH, CONV_WIDTH, N_BRANCH * D_MODEL)
IN_COLS = int(sum(IN_SIZES))
SPLIT_POINTS = tuple(int(v) for v in np.cumsum(IN_SIZES)[:-1])

kernel_name = "hybrid_gated_diffattn_pool_conv_block"


def layer_norm(x, g, b):
    xf = x.astype(jnp.float32)
    mu = jnp.mean(xf, axis=-1, keepdims=True)
    var = jnp.mean(jnp.square(xf - mu), axis=-1, keepdims=True)
    return ((xf - mu) * lax.rsqrt(var + LN_EPS) * g.astype(jnp.float32)
            + b.astype(jnp.float32)).astype(x.dtype)


def rms_norm(x, g):
    xf = x.astype(jnp.float32)
    ms = jnp.mean(jnp.square(xf), axis=-1, keepdims=True)
    return xf * lax.rsqrt(ms + RMS_EPS) * g.astype(jnp.float32)


def diff_attn_block(q_blk, q_pos, k, v, lam):
    s = jnp.einsum('bhmqd,bhmkd->bhmqk', q_blk, k,
                   preferred_element_type=jnp.float32) * (ATTN_D ** -0.5)
    visible = jnp.arange(k.shape[3])[None, :] <= q_pos[:, None]
    s = jnp.where(visible, s, NEG_INF)
    p = jax.nn.softmax(s, axis=-1)
    a = p[:, :, 0] - lam * p[:, :, 1]
    return jnp.einsum('bhqk,bhke->bhqe', a, v)


def diff_attention(q, k, v, lam, lam_init, subln_g):
    B, L = q.shape[0], q.shape[1]
    n_real = L - N_META
    n_blk = n_real // Q_BLOCK
    qh = q.reshape(B, L, ATTN_HEADS, 2, ATTN_D).transpose(0, 2, 3, 1, 4)
    kh = k.reshape(B, L, ATTN_HEADS, 2, ATTN_D).transpose(0, 2, 3, 1, 4)
    vh = v.reshape(B, L, ATTN_HEADS, 2 * ATTN_D).transpose(0, 2, 1, 3).astype(jnp.float32)
    pos = jnp.arange(L)
    o_meta = diff_attn_block(qh[:, :, :, :N_META], pos[:N_META], kh, vh, lam)
    q_real = qh[:, :, :, N_META:].reshape(B, ATTN_HEADS, 2, n_blk, Q_BLOCK, ATTN_D)
    q_real = q_real.transpose(3, 0, 1, 2, 4, 5)
    pos_real = pos[N_META:].reshape(n_blk, Q_BLOCK)
    o_real = lax.map(lambda a: diff_attn_block(a[0], a[1], kh, vh, lam), (q_real, pos_real))
    o_real = o_real.transpose(1, 2, 0, 3, 4).reshape(B, ATTN_HEADS, n_real, 2 * ATTN_D)
    o = jnp.concatenate([o_meta, o_real], axis=2)
    o = rms_norm(o, subln_g) * (1.0 - lam_init)
    return o.transpose(0, 2, 1, 3).reshape(B, L, ATTN_WIDTH).astype(q.dtype)


def multiscale_pool(u, pool_w, pool_scale):
    B, L = u.shape[0], u.shape[1]
    ug = u.reshape(B, L, POOL_GROUPS, POOL_GROUP_DIM).astype(jnp.float32)
    csum = jnp.cumsum(ug, axis=1)
    n_avail = jnp.arange(1, L + 1)
    outs = []
    for g, w in enumerate(POOL_WINDOWS):
        cg = csum[:, :, g]
        prev = jnp.pad(cg, ((0, 0), (w, 0), (0, 0)))[:, :L]
        cnt = jnp.minimum(n_avail, w).astype(jnp.float32)[None, :, None]
        outs.append((cg - prev) / cnt - ug[:, :, g])
    pooled = jnp.stack(outs, axis=2).astype(u.dtype)
    mixed = jnp.einsum('blgc,gcd->blgd', pooled, pool_w)
    return mixed.reshape(B, L, POOL_WIDTH) * pool_scale


def short_gated_conv(u, gate_b, gate_c, conv_w):
    L = u.shape[1]
    h = gate_c * u
    hp = jnp.pad(h, ((0, 0), (CONV_K - 1, 0), (0, 0)))
    y = conv_w[0] * hp[:, 0:L]
    for j in range(1, CONV_K):
        y = y + conv_w[j] * hp[:, j:j + L]
    return gate_b * y


def setup_inputs(seed: int = 0) -> dict:
    key = jax.random.key(seed)
    ks = jax.random.split(key, 24)
    f32 = jnp.float32
    nrm = lambda k, shape, scale: jax.random.normal(k, shape, f32) * scale
    d = DEPTH
    return {
        "x": nrm(ks[0], (BATCH, SEQ, D_MODEL), 1.0),
        "meta_tokens": nrm(ks[1], (N_META, D_MODEL), 1.0),
        "emb_ln_g": 1.0 + nrm(ks[2], (D_MODEL,), 0.02),
        "emb_ln_b": nrm(ks[3], (D_MODEL,), 0.02),
        "w_in": nrm(ks[4], (d, D_MODEL, IN_COLS), D_MODEL ** -0.5),
        "b_gate": nrm(ks[5], (d, N_BRANCH * D_MODEL), 0.02),
        "lam_q1": nrm(ks[6], (d, ATTN_D), 0.1),
        "lam_k1": nrm(ks[7], (d, ATTN_D), 0.1),
        "lam_q2": nrm(ks[8], (d, ATTN_D), 0.1),
        "lam_k2": nrm(ks[9], (d, ATTN_D), 0.1),
        "attn_subln_g": 1.0 + nrm(ks[10], (d, 2 * ATTN_D), 0.02),
        "w_attn_br": nrm(ks[11], (d, ATTN_WIDTH, D_MODEL), ATTN_WIDTH ** -0.5),
        "pool_w": nrm(ks[12], (d, POOL_GROUPS, POOL_GROUP_DIM, POOL_GROUP_DIM), POOL_GROUP_DIM ** -0.5),
        "pool_scale": 1.0 + nrm(ks[13], (d, POOL_WIDTH), 0.02),
        "w_pool_br": nrm(ks[14], (d, POOL_WIDTH, D_MODEL), POOL_WIDTH ** -0.5),
        "conv_w": nrm(ks[15], (d, CONV_K, CONV_WIDTH), CONV_K ** -0.5),
        "w_conv_br": nrm(ks[16], (d, CONV_WIDTH, D_MODEL), CONV_WIDTH ** -0.5),
        "w_o": nrm(ks[17], (d, D_MODEL, D_MODEL), D_MODEL ** -0.5 * DEEPNORM_BETA),
        "ln1_g": 1.0 + nrm(ks[18], (d, D_MODEL), 0.02),
        "ln1_b": nrm(ks[19], (d, D_MODEL), 0.02),
        "w_ff1": nrm(ks[20], (d, D_MODEL, D_FF), D_MODEL ** -0.5),
        "w_ff2": nrm(ks[21], (d, D_FF, D_MODEL), D_FF ** -0.5 * DEEPNORM_BETA),
        "ln2_g": 1.0 + nrm(ks[22], (d, D_MODEL), 0.02),
        "ln2_b": nrm(ks[23], (d, D_MODEL), 0.02),
    }


def reference(x, meta_tokens, emb_ln_g, emb_ln_b, w_in, b_gate, lam_q1, lam_k1, lam_q2, lam_k2,
              attn_subln_g, w_attn_br, pool_w, pool_scale, w_pool_br, conv_w, w_conv_br, w_o,
              ln1_g, ln1_b, w_ff1, w_ff2, ln2_g, ln2_b):
    B, S, D = x.shape
    L = S + N_META
    meta = jnp.broadcast_to(meta_tokens[None].astype(x.dtype), (B, N_META, D))
    h = layer_norm(jnp.concatenate([meta, x], axis=1), emb_ln_g, emb_ln_b)
    for l in range(DEPTH):
        proj = jnp.einsum('bld,dc->blc', h, w_in[l])
        q, k, v, u_pool, u_conv, g_b, g_c, gate_logits = jnp.split(proj, SPLIT_POINTS, axis=-1)
        lam_init = 0.8 - 0.6 * float(np.exp(-0.3 * l))
        lam = (jnp.exp(jnp.sum(lam_q1[l].astype(jnp.float32) * lam_k1[l].astype(jnp.float32)))
               - jnp.exp(jnp.sum(lam_q2[l].astype(jnp.float32) * lam_k2[l].astype(jnp.float32)))
               + lam_init)
        y_attn = diff_attention(q, k, v, lam, lam_init, attn_subln_g[l])
        y_pool = multiscale_pool(u_pool, pool_w[l], pool_scale[l])
        y_conv = short_gated_conv(u_conv, g_b, g_c, conv_w[l])
        br_attn = jnp.einsum('blc,cd->bld', y_attn, w_attn_br[l])
        br_pool = jnp.einsum('blc,cd->bld', y_pool, w_pool_br[l])
        br_conv = jnp.einsum('blc,cd->bld', y_conv, w_conv_br[l])
        gates = jax.nn.sigmoid((gate_logits + b_gate[l]).astype(jnp.float32)).astype(h.dtype)
        gates = gates.reshape(B, L, N_BRANCH, D)
        merged = gates[:, :, 0] * br_attn + gates[:, :, 1] * br_pool + gates[:, :, 2] * br_conv
        mix = jnp.einsum('bld,de->ble', merged, w_o[l])
        h = layer_norm(DEEPNORM_ALPHA * h + mix, ln1_g[l], ln1_b[l])
        ff = jnp.square(jax.nn.relu(jnp.einsum('bld,df->blf', h, w_ff1[l])))
        ff = jnp.einsum('blf,fd->bld', ff, w_ff2[l])
        h = layer_norm(DEEPNORM_ALPHA * h + ff, ln2_g[l], ln2_b[l])
    return h[:, N_META:]
```

```cpp
#include <hip/hip_runtime.h>
#include <hip/hip_cooperative_groups.h>
#include <cstdio>
#include <cstdint>
namespace cg = cooperative_groups;
constexpr int BATCH = 2, SEQ = 8192, NMETA = 16, LSEQ = SEQ + NMETA, DMODEL = 2048, DEPTH = 2;
constexpr int MROWS = BATCH * LSEQ;
constexpr int MP = 16640;
constexpr int MPA = MP + 256;
constexpr int TAIL0 = 16384;
constexpr int INC = 13312, DFF = 8192;
constexpr float LN_EPS = 1e-5f, RMS_EPS = 1e-5f;
constexpr float DN_ALPHA = 1.41421356237f;
namespace pg8 {
#define PG8_LAS __attribute__((address_space(3)))
typedef unsigned short bf16_t;
typedef short bf16x8 __attribute__((ext_vector_type(8)));
typedef float f32x4 __attribute__((ext_vector_type(4)));
typedef unsigned u32x4 __attribute__((ext_vector_type(4)));
constexpr int BM = 256, BK = 64, HALF = 128, HTB = HALF * BK * 2  , STAGE_BYTES = 8 * HTB, NXCD = 8, WGM = 8;

__host__ __device__ __forceinline__ int lds_byte(int r, int c) { const int st = (r >> 4) * 2 + (c >> 5), rr = r & 15, cc = c & 31, ob = rr * 64 + cc * 2; return st * 1024 + (ob ^ (((ob >> 9) & 1) << 5)); }
__host__ __device__ __forceinline__ void stage_rc(int b, int& R, int& C) { const int st = b / 1024, sb = b % 1024, swz = sb ^ (((sb >> 9) & 1) << 5); R = (st >> 1) * 16 + swz / 64; C = (st & 1) * 32 + (swz % 64) / 2; }
__host__ __device__ __forceinline__ int perm32(int rho) { const int n = rho >> 4, i = rho & 15; return 8 * (i >> 2) + 4 * n + (i & 3); }

struct Unit { int pm, pn, br, kc; };
struct Gemm { const bf16_t* A; const bf16_t* Bt; int M, N, K, lda, ldb; unsigned a_pn, a_br, b_br, a_kc, b_kc; };

struct StaticOrder {
    int nM, nN, nwg, G, c;
    __host__ __device__ void init(int M, int N, int G_, int c_) { nM = M / BM; nN = N / BM; nwg = nM * nN; G = G_; c = c_; }
    __host__ __device__ bool next(int i, Unit& u) const {
        const long L = (long)i * G + c; if (L >= nwg) return false;
        int wgid = (int)L; { const int q = nwg / NXCD, r = nwg % NXCD, xcd = wgid % NXCD, off = wgid / NXCD; wgid = (xcd < r ? xcd * (q + 1) : r * (q + 1) + (xcd - r) * q) + off; }
        const int nig = WGM * nN, gid = wgid / nig, fm = gid * WGM, gsz = (nM - fm) < WGM ? (nM - fm) : WGM;
        u.pm = fm + ((wgid % nig) % gsz); u.pn = (wgid % nig) / gsz; u.br = 0; u.kc = 0; return true;
    }
    __device__ __forceinline__ void a_ready(const Unit&) const {}
    __device__ __forceinline__ void done(const Unit&) const {}
};

typedef float f32x2c_t __attribute__((ext_vector_type(2))); typedef __bf16 bf16x2c_t __attribute__((ext_vector_type(2)));
__device__ __forceinline__ unsigned cvt_pk_bf16(float lo, float hi) { const f32x2c_t v = {lo, hi}; const bf16x2c_t b = __builtin_convertvector(v, bf16x2c_t); return __builtin_bit_cast(unsigned, b); }
struct BranchOrder {
    StaticOrder so;
    __host__ __device__ void init(int M, int N, int G_, int c_) { so.init(M, N, G_, c_); }
    __host__ __device__ bool next(int i, Unit& u) const { const int it = i / 3; if (!so.next(it, u)) return false; u.br = i - 3 * it; return true; }
    __device__ __forceinline__ void a_ready(const Unit&) const {}
    __device__ __forceinline__ void done(const Unit&) const {}
};
typedef float f32x2 __attribute__((ext_vector_type(2)));
__device__ __forceinline__ float bf_lo(unsigned w) { return __uint_as_float(w << 16); }
__device__ __forceinline__ float bf_hi(unsigned w) { return __uint_as_float(w & 0xffff0000u); }
__device__ __forceinline__ float sigmoid_f(float x) { return __builtin_amdgcn_rcpf(1.0f + __builtin_amdgcn_exp2f(-1.44269504089f * x)); }
__device__ __forceinline__ u32x4 pack8(const f32x4 v0, const f32x4 v1) { u32x4 w; w.x = cvt_pk_bf16(v0[0], v0[1]); w.y = cvt_pk_bf16(v0[2], v0[3]); w.z = cvt_pk_bf16(v1[0], v1[1]); w.w = cvt_pk_bf16(v1[2], v1[3]); return w; }

struct EpiInProj {
    static constexpr bool PERM = true, AFTER_DRAIN = false;
    bf16_t* QKV; bf16_t* U4; bf16_t* G; const float* bgate; float qscale;
    __device__ __forceinline__ void operator()(const f32x4 (&acc)[2][2][4][2], const Unit& u, int wr, int wc, int fr, int fq) const {
        const int row0 = u.pm * BM + wr * 64 + fr; const int colt = u.pn * BM, t = colt >> 10, cin = (colt & 1023) + wc * 32 + 8 * fq;
        if (t < 7) {
            bf16_t* base; int ldc; float sc = 1.f;
            if (t < 3) { base = QKV + t * 1024 + cin; ldc = 3072; if (t == 0) sc = qscale; }
            else { base = U4 + (size_t)(t - 3) * MP * 1024 + cin; ldc = 1024; }
#pragma unroll
            for (int ai = 0; ai < 2; ++ai)
#pragma unroll
                for (int m = 0; m < 4; ++m) { bf16_t* rowp = base + (size_t)(row0 + ai * HALF + m * 16) * ldc;
#pragma unroll
                    for (int bj = 0; bj < 2; ++bj) *(u32x4*)(rowp + bj * HALF) = pack8(acc[ai][bj][m][0] * sc, acc[ai][bj][m][1] * sc); }
        } else {
            const int gc = (t - 7) * 1024 + cin, gt = u.pn - 28, tid8 = (((wr * 4 + wc) * 64) + fq * 16 + fr) * 8; bf16_t* gb = G + ((size_t)(u.pm * 24 + gt) * 16) * 4096 + tid8;
            f32x4 bv[2][2];
#pragma unroll
            for (int bj = 0; bj < 2; ++bj)
#pragma unroll
                for (int n = 0; n < 2; ++n) bv[bj][n] = *(const f32x4*)(bgate + gc + bj * HALF + 4 * n);
#pragma unroll
            for (int ai = 0; ai < 2; ++ai)
#pragma unroll
                for (int m = 0; m < 4; ++m)
#pragma unroll
                    for (int bj = 0; bj < 2; ++bj) { f32x4 v0 = acc[ai][bj][m][0] + bv[bj][0], v1 = acc[ai][bj][m][1] + bv[bj][1];
#pragma unroll
                        for (int e = 0; e < 4; ++e) { v0[e] = sigmoid_f(v0[e]); v1[e] = sigmoid_f(v1[e]); }
                        __builtin_nontemporal_store(pack8(v0, v1), (u32x4*)(gb + (size_t)((ai * 4 + m) * 2 + bj) * 4096)); }
        }
    }
};
struct EpiRelu2 {
    static constexpr bool PERM = true, AFTER_DRAIN = false;
    bf16_t* O; int ldc;
    __device__ __forceinline__ void operator()(const f32x4 (&acc)[2][2][4][2], const Unit& u, int wr, int wc, int fr, int fq) const {
        const int row0 = u.pm * BM + wr * 64 + fr, col0 = u.pn * BM + wc * 32 + 8 * fq;
#pragma unroll
        for (int ai = 0; ai < 2; ++ai)
#pragma unroll
            for (int m = 0; m < 4; ++m) { bf16_t* rowp = O + (size_t)(row0 + ai * HALF + m * 16) * ldc + col0;
#pragma unroll
                for (int bj = 0; bj < 2; ++bj) { f32x4 v0 = acc[ai][bj][m][0], v1 = acc[ai][bj][m][1];
#pragma unroll
                    for (int e = 0; e < 4; ++e) { const float a = fmaxf(v0[e], 0.f), b = fmaxf(v1[e], 0.f); v0[e] = a * a; v1[e] = b * b; }
                    *(u32x4*)(rowp + bj * HALF) = pack8(v0, v1); } }
    }
};
struct EpiResid {
    static constexpr bool PERM = true, AFTER_DRAIN = false;
    float* H; float alpha;
    __device__ __forceinline__ void operator()(const f32x4 (&acc)[2][2][4][2], const Unit& u, int wr, int wc, int fr, int fq) const {
        const int row0 = u.pm * BM + wr * 64 + fr, col0 = u.pn * BM + wc * 32 + 8 * fq;
#pragma unroll
        for (int ai = 0; ai < 2; ++ai)
#pragma unroll
            for (int m = 0; m < 4; ++m) { float* rowp = H + (size_t)(row0 + ai * HALF + m * 16) * DMODEL + col0;
#pragma unroll
                for (int bj = 0; bj < 2; ++bj) { f32x4* p = (f32x4*)(rowp + bj * HALF); const f32x4 h0 = p[0], h1 = p[1];
                    p[0] = h0 * alpha + acc[ai][bj][m][0]; p[1] = h1 * alpha + acc[ai][bj][m][1]; }
                if (m & 1) asm volatile("" ::: "memory"); }
    }
};
struct EpiResidBf {
    static constexpr bool PERM = true, AFTER_DRAIN = false;
    float* H; const bf16_t* HNb; float alpha;
    __device__ __forceinline__ void operator()(const f32x4 (&acc)[2][2][4][2], const Unit& u, int wr, int wc, int fr, int fq) const {
        const int row0 = u.pm * BM + wr * 64 + fr, col0 = u.pn * BM + wc * 32 + 8 * fq;
#pragma unroll
        for (int ai = 0; ai < 2; ++ai)
#pragma unroll
            for (int m = 0; m < 4; ++m) { const size_t ro = (size_t)(row0 + ai * HALF + m * 16) * DMODEL + col0;
#pragma unroll
                for (int bj = 0; bj < 2; ++bj) { const u32x4 hw = *(const u32x4*)(HNb + ro + bj * HALF); f32x4* p = (f32x4*)(H + ro + bj * HALF);
                    p[0] = (f32x4){bf_lo(hw.x), bf_hi(hw.x), bf_lo(hw.y), bf_hi(hw.y)} * alpha + acc[ai][bj][m][0];
                    p[1] = (f32x4){bf_lo(hw.z), bf_hi(hw.z), bf_lo(hw.w), bf_hi(hw.w)} * alpha + acc[ai][bj][m][1]; }
                if (m & 1) asm volatile("" ::: "memory"); }
    }
};
struct EpiResidV {
    static constexpr bool PERM = true, AFTER_DRAIN = false;
    bf16_t* V; const bf16_t* HNb; float alpha;
    __device__ __forceinline__ void operator()(const f32x4 (&acc)[2][2][4][2], const Unit& u, int wr, int wc, int fr, int fq) const {
        const int row0 = u.pm * BM + wr * 64 + fr, col0 = u.pn * BM + wc * 32 + 8 * fq;
#pragma unroll
        for (int ai = 0; ai < 2; ++ai)
#pragma unroll
            for (int m = 0; m < 4; ++m) { const size_t ro = (size_t)(row0 + ai * HALF + m * 16) * DMODEL + col0;
#pragma unroll
                for (int bj = 0; bj < 2; ++bj) { const u32x4 hw = *(const u32x4*)(HNb + ro + bj * HALF);
                    const f32x4 v0 = (f32x4){bf_lo(hw.x), bf_hi(hw.x), bf_lo(hw.y), bf_hi(hw.y)} * alpha + acc[ai][bj][m][0], v1 = (f32x4){bf_lo(hw.z), bf_hi(hw.z), bf_lo(hw.w), bf_hi(hw.w)} * alpha + acc[ai][bj][m][1];
                    *(u32x4*)(V + ro + bj * HALF) = pack8(v0, v1); }
                if (m & 1) asm volatile("" ::: "memory"); }
    }
};
struct EpiBranch {
    static constexpr bool PERM = true, AFTER_DRAIN = false;
    const bf16_t* G; bf16_t* MG; bf16_t* PS;
    __device__ __forceinline__ void operator()(const f32x4 (&acc)[2][2][4][2], const Unit& u, int wr, int wc, int fr, int fq) const {
        const int row0 = u.pm * BM + wr * 64 + fr, col0 = u.pn * BM + wc * 32 + 8 * fq; const int br = u.br, tid8 = (((wr * 4 + wc) * 64) + fq * 16 + fr) * 8;
        const bf16_t* gb = G + ((size_t)(u.pm * 24 + br * 8 + u.pn) * 16) * 4096 + tid8; bf16_t* pb = PS + ((size_t)(u.pm * 8 + u.pn) * 16) * 4096 + tid8;
#pragma unroll
        for (int ai = 0; ai < 2; ++ai) {
            u32x4 gw[4][2], pw[4][2];
#pragma unroll
            for (int m = 0; m < 4; ++m)
#pragma unroll
                for (int bj = 0; bj < 2; ++bj) { const size_t so = (size_t)((ai * 4 + m) * 2 + bj) * 4096; gw[m][bj] = __builtin_nontemporal_load((const u32x4*)(gb + so)); pw[m][bj] = (u32x4){0u, 0u, 0u, 0u}; if (br > 0) pw[m][bj] = __builtin_nontemporal_load((const u32x4*)(pb + so)); }
#pragma unroll
            for (int m = 0; m < 4; ++m) { bf16_t* mp = MG + (size_t)(row0 + ai * HALF + m * 16) * DMODEL + col0;
#pragma unroll
                for (int bj = 0; bj < 2; ++bj) { const u32x4 g = gw[m][bj], p = pw[m][bj]; f32x4 v0 = acc[ai][bj][m][0], v1 = acc[ai][bj][m][1];
                    v0[0] = v0[0] * bf_lo(g.x) + bf_lo(p.x); v0[1] = v0[1] * bf_hi(g.x) + bf_hi(p.x); v0[2] = v0[2] * bf_lo(g.y) + bf_lo(p.y); v0[3] = v0[3] * bf_hi(g.y) + bf_hi(p.y);
                    v1[0] = v1[0] * bf_lo(g.z) + bf_lo(p.z); v1[1] = v1[1] * bf_hi(g.z) + bf_hi(p.z); v1[2] = v1[2] * bf_lo(g.w) + bf_lo(p.w); v1[3] = v1[3] * bf_hi(g.w) + bf_hi(p.w);
                    const u32x4 o = pack8(v0, v1);
                    if (br < 2) *(u32x4*)(pb + (size_t)((ai * 4 + m) * 2 + bj) * 4096) = o; else *(u32x4*)(mp + bj * HALF) = o; } }
            asm volatile("" ::: "memory");
        }
    }
};
struct EpiStore {
    static constexpr bool PERM = true, AFTER_DRAIN = false;
    bf16_t* Y; int ldc;
    __device__ __forceinline__ void operator()(const f32x4 (&acc)[2][2][4][2], const Unit& u, int wr, int wc, int fr, int fq) const {
        const int row0 = u.pm * BM + wr * 64 + fr, col0 = u.pn * BM + wc * 32 + 8 * fq;
#pragma unroll
        for (int ai = 0; ai < 2; ++ai)
#pragma unroll
            for (int m = 0; m < 4; ++m)
#pragma unroll
                for (int bj = 0; bj < 2; ++bj) *(u32x4*)(Y + (size_t)(row0 + ai * HALF + m * 16) * ldc + col0 + bj * HALF) = pack8(acc[ai][bj][m][0], acc[ai][bj][m][1]);
    }
};
struct EpiPool {
    static constexpr bool PERM = true, AFTER_DRAIN = false;
    bf16_t* Y; const float* scale;
    __device__ __forceinline__ void operator()(const f32x4 (&acc)[2][2][4][2], const Unit& u, int wr, int wc, int fr, int fq) const {
        const int row0 = u.pm * BM + wr * 64 + fr, col0 = u.pn * BM + wc * 32 + 8 * fq;
#pragma unroll
        for (int bj = 0; bj < 2; ++bj) { const f32x4 s0 = *(const f32x4*)(scale + col0 + bj * HALF), s1 = *(const f32x4*)(scale + col0 + bj * HALF + 4);
#pragma unroll
            for (int ai = 0; ai < 2; ++ai)
#pragma unroll
                for (int m = 0; m < 4; ++m) *(u32x4*)(Y + (size_t)(row0 + ai * HALF + m * 16) * 3072 + 1024 + col0 + bj * HALF) = pack8(acc[ai][bj][m][0] * s0, acc[ai][bj][m][1] * s1);
            asm volatile("" ::: "memory"); }
    }
};

struct TailOrder {
    int njobs, nN, G, c;
    __host__ __device__ void init(int nN_, int nK, int G_, int c_) { njobs = nN_ * nK; nN = nN_; G = G_; c = c_; }
    __host__ __device__ bool next(int i, Unit& u) const { const int j = i * G + c; if (j >= njobs) return false; u.pm = 0; u.pn = j % nN; u.br = j / nN; u.kc = 0; return true; }
    __device__ __forceinline__ void a_ready(const Unit&) const {}
    __device__ __forceinline__ void done(const Unit&) const {}
};
struct EpiTailAtomic {
    static constexpr bool PERM = true, AFTER_DRAIN = false;
    float* H; int ld;
    __device__ __forceinline__ void operator()(const f32x4 (&acc)[2][2][4][2], const Unit& u, int wr, int wc, int fr, int fq) const {
        if (wr != 0) return;
        const int col0 = u.pn * BM + wc * 32 + 8 * fq;
#pragma unroll
        for (int m = 0; m < 2; ++m) { float* rowp = H + (size_t)(m * 16 + fr) * ld + col0;
#pragma unroll
            for (int bj = 0; bj < 2; ++bj)
#pragma unroll
                for (int n = 0; n < 2; ++n)
#pragma unroll
                    for (int e = 0; e < 4; ++e) unsafeAtomicAdd(rowp + bj * HALF + 4 * n + e, acc[0][bj][m][n][e]); }
    }
};

struct TailOrder3 {
    int G, c;
    __host__ __device__ void init(int G_, int c_) { G = G_; c = c_; }
    __host__ __device__ bool next(int i, Unit& u) const { const int j = i * G + c; if (j >= 96) return false; u.pm = 0; u.pn = j & 7; u.br = (j >> 3) % 3; u.kc = j / 24; return true; }
    __device__ __forceinline__ void a_ready(const Unit&) const {}
    __device__ __forceinline__ void done(const Unit&) const {}
};
struct EpiTailGateAtomic {
    static constexpr bool PERM = true, AFTER_DRAIN = false;
    float* T; const bf16_t* Gt;
    __device__ __forceinline__ void operator()(const f32x4 (&acc)[2][2][4][2], const Unit& u, int wr, int wc, int fr, int fq) const {
        if (wr != 0) return;
        const int col0 = u.pn * BM + wc * 32 + 8 * fq;
#pragma unroll
        for (int m = 0; m < 2; ++m) { const int r = m * 16 + fr; float* rowp = T + (size_t)r * DMODEL + col0; const bf16_t* gp = Gt + (size_t)r * 6144 + u.br * 2048 + col0;
#pragma unroll
            for (int bj = 0; bj < 2; ++bj) { const u32x4 gw = *(const u32x4*)(gp + bj * HALF); const f32x4 a0 = acc[0][bj][m][0], a1 = acc[0][bj][m][1]; float* p = rowp + bj * HALF;
                unsafeAtomicAdd(p + 0, a0[0] * bf_lo(gw.x)); unsafeAtomicAdd(p + 1, a0[1] * bf_hi(gw.x)); unsafeAtomicAdd(p + 2, a0[2] * bf_lo(gw.y)); unsafeAtomicAdd(p + 3, a0[3] * bf_hi(gw.y));
                unsafeAtomicAdd(p + 4, a1[0] * bf_lo(gw.z)); unsafeAtomicAdd(p + 5, a1[1] * bf_hi(gw.z)); unsafeAtomicAdd(p + 6, a1[2] * bf_lo(gw.w)); unsafeAtomicAdd(p + 7, a1[3] * bf_hi(gw.w)); } }
    }
};
template <class Epi, class Sched, bool ALIGN_EPI = false, bool SP2 = false>
__device__ __forceinline__ void gemm_phase(PG8_LAS unsigned char* lds, const Gemm g, const Sched& S, const Epi& E) {
    int tid_ = threadIdx.x; asm volatile("" : "+v"(tid_)); const int tid = tid_, wid = __builtin_amdgcn_readfirstlane(tid >> 6), lane = tid & 63, wr = wid >> 2, wc = wid & 3, fr = lane & 15, fq = lane >> 4;
    const int K = g.K, nt = K / BK;
    unsigned voffA[2], voffB[2];
#pragma unroll
    for (int i = 0; i < 2; ++i) { int R, C; stage_rc(tid * 16 + i * 8192, R, C); const int Rb = Epi::PERM ? ((R & ~31) + perm32(R & 31)) : R;
        voffA[i] = (unsigned)(R * g.lda + C) * 2u; voffB[i] = (unsigned)(Rb * g.ldb + C) * 2u; }
    const size_t kstep = (size_t)(BK * 2);
    const size_t hstepA = (size_t)HALF * g.lda * 2, hstepB = (size_t)HALF * g.ldb * 2;
    const size_t tstepA = 2 * hstepA, tstepB = 2 * hstepB;
#define PG8_UA(u) ((const char*)g.A + (size_t)(u).pm * tstepA + (size_t)(u).pn * g.a_pn + (size_t)(u).br * g.a_br + (size_t)(u).kc * g.a_kc)
#define PG8_UB(u) ((const char*)g.Bt + (size_t)(u).pn * tstepB + (size_t)(u).br * g.b_br + (size_t)(u).kc * g.b_kc)
    const unsigned ldsw = (unsigned)wid * 1024u;
    const int aoff = lds_byte(wr * 64 + fr, fq * 8), boff = lds_byte(wc * 32 + fr, fq * 8);
#define PG8_SA(b, h) (((b) * 2 + (h)) * HTB)
#define PG8_SB(b, h) ((4 + (b) * 2 + (h)) * HTB)
#define PG8_STAGE(bufoff, gbase, voff) do { _Pragma("unroll") for (int _i = 0; _i < 2; ++_i) \
        __builtin_amdgcn_global_load_lds((const unsigned*)((const char*)(gbase) + (voff)[_i]), (PG8_LAS unsigned*)(lds + (bufoff) + ldsw + _i * 8192), 16, 0, 0); } while (0)
#define PG8_LDA(dst, b, h) do { _Pragma("unroll") for (int m = 0; m < 4; ++m) _Pragma("unroll") for (int k = 0; k < 2; ++k) dst[m][k] = *(const PG8_LAS bf16x8*)(lds + PG8_SA(b, h) + aoff + m * 2048 + k * 1024); } while (0)
#define PG8_LDB(dst, b, h) do { _Pragma("unroll") for (int n = 0; n < 2; ++n) _Pragma("unroll") for (int k = 0; k < 2; ++k) dst[n][k] = *(const PG8_LAS bf16x8*)(lds + PG8_SB(b, h) + boff + n * 2048 + k * 1024); } while (0)
#define PG8_MMA(ai, bj, At, Bt) do { __builtin_amdgcn_s_setprio(1); _Pragma("unroll") for (int m = 0; m < 4; ++m) _Pragma("unroll") for (int n = 0; n < 2; ++n) _Pragma("unroll") for (int k = 0; k < 2; ++k) \
        acc[ai][bj][m][n] = __builtin_amdgcn_mfma_f32_16x16x32_bf16(Bt[n][k], At[m][k], acc[ai][bj][m][n], 0, 0, 0); __builtin_amdgcn_s_setprio(0); } while (0)
#define PG8_WAIT_V(n) asm volatile("s_waitcnt vmcnt(" #n ")" ::: "memory")
#define PG8_WAIT_L(n) asm volatile("s_waitcnt lgkmcnt(" #n ")" ::: "memory")
#define PG8_BAR __builtin_amdgcn_s_barrier()
#define PG8_SCHED __builtin_amdgcn_sched_barrier(0)
    Unit cur, nxt; int ui = 0;
    if (!S.next(0, cur)) return;
    f32x4 acc[2][2][4][2];
#pragma unroll
    for (int a = 0; a < 2; ++a)
#pragma unroll
        for (int b = 0; b < 2; ++b)
#pragma unroll
            for (int m = 0; m < 4; ++m)
#pragma unroll
                for (int n = 0; n < 2; ++n) acc[a][b][m][n] = (f32x4){0.f, 0.f, 0.f, 0.f};
    bf16x8 At[4][2], B0[2][2], B1[2][2];
    const char* cA = PG8_UA(cur); const char* cB = PG8_UB(cur);
    S.a_ready(cur);
    if constexpr (SP2) {
        PG8_STAGE(PG8_SB(0, 0), cB, voffB); PG8_STAGE(PG8_SB(0, 1), cB + hstepB, voffB); PG8_STAGE(PG8_SA(0, 0), cA, voffA); PG8_STAGE(PG8_SA(0, 1), cA + hstepA, voffA);
        if (wr == 1) PG8_BAR;
        PG8_WAIT_V(2); PG8_BAR;
        PG8_STAGE(PG8_SB(1, 0), cB + kstep, voffB); PG8_STAGE(PG8_SA(1, 0), cA + kstep, voffA); PG8_STAGE(PG8_SB(1, 1), cB + hstepB + kstep, voffB);
        PG8_WAIT_V(6); PG8_BAR;
    } else {
        PG8_STAGE(PG8_SB(0, 0), cB, voffB); PG8_STAGE(PG8_SA(0, 0), cA, voffA); PG8_STAGE(PG8_SB(0, 1), cB + hstepB, voffB); PG8_STAGE(PG8_SA(0, 1), cA + hstepA, voffA);
        if (wr == 1) PG8_BAR;
        PG8_WAIT_V(4); PG8_BAR;
        PG8_STAGE(PG8_SB(1, 0), cB + kstep, voffB); PG8_STAGE(PG8_SA(1, 0), cA + kstep, voffA); PG8_STAGE(PG8_SB(1, 1), cB + hstepB + kstep, voffB);
        PG8_WAIT_V(6); PG8_BAR;
    }
    for (;;) {
        const bool has_next = S.next(ui + 1, nxt);
        const char* nA = has_next ? PG8_UA(nxt) : cA; const char* nB = has_next ? PG8_UB(nxt) : cB;
        for (int t = 0; t < nt; t += 2) {
            const bool last = (t == nt - 2);
            const char* a1 = cA + (size_t)(t + 1) * kstep;
            const char* a2 = last ? nA : cA + (size_t)(t + 2) * kstep; const char* b2 = last ? nB : cB + (size_t)(t + 2) * kstep;
            const char* a3 = a2 + kstep; const char* b3 = b2 + kstep;
            if (last && has_next) S.a_ready(nxt);
            if constexpr (SP2) {
            PG8_LDB(B0, 0, 0); PG8_LDB(B1, 0, 1); PG8_SCHED; PG8_LDA(At, 0, 0); PG8_STAGE(PG8_SA(1, 1), a1 + hstepA, voffA);
            PG8_WAIT_V(8); PG8_WAIT_L(0); PG8_BAR; PG8_MMA(0, 0, At, B0); PG8_MMA(0, 1, At, B1); PG8_BAR; PG8_SCHED;
            PG8_LDA(At, 0, 1); PG8_STAGE(PG8_SB(0, 0), b2, voffB); PG8_STAGE(PG8_SB(0, 1), b2 + hstepB, voffB); PG8_STAGE(PG8_SA(0, 0), a2, voffA);
            PG8_WAIT_V(8); PG8_WAIT_L(0); PG8_BAR; PG8_MMA(1, 0, At, B0); PG8_MMA(1, 1, At, B1); PG8_BAR; PG8_SCHED;
            PG8_LDB(B0, 1, 0); PG8_LDB(B1, 1, 1); PG8_SCHED; PG8_LDA(At, 1, 0); PG8_STAGE(PG8_SA(0, 1), a2 + hstepA, voffA);
            PG8_WAIT_V(8); PG8_WAIT_L(0); PG8_BAR; PG8_MMA(0, 0, At, B0); PG8_MMA(0, 1, At, B1); PG8_BAR; PG8_SCHED;
            PG8_LDA(At, 1, 1); PG8_STAGE(PG8_SB(1, 0), b3, voffB); PG8_STAGE(PG8_SB(1, 1), b3 + hstepB, voffB); PG8_STAGE(PG8_SA(1, 0), a3, voffA);
            PG8_WAIT_V(8); PG8_WAIT_L(0); PG8_BAR; PG8_MMA(1, 0, At, B0); PG8_MMA(1, 1, At, B1); PG8_BAR; PG8_SCHED;
            } else {
            PG8_LDB(B0, 0, 0); PG8_SCHED; PG8_LDA(At, 0, 0); PG8_STAGE(PG8_SA(1, 1), a1 + hstepA, voffA);
            PG8_WAIT_L(8); PG8_BAR; PG8_WAIT_L(0); PG8_MMA(0, 0, At, B0); PG8_BAR; PG8_SCHED;
            PG8_LDB(B1, 0, 1); PG8_STAGE(PG8_SB(0, 0), b2, voffB);
            PG8_BAR; PG8_WAIT_L(0); PG8_MMA(0, 1, At, B1); PG8_BAR;
            PG8_LDA(At, 0, 1); PG8_STAGE(PG8_SA(0, 0), a2, voffA);
            PG8_BAR; PG8_WAIT_L(0); PG8_MMA(1, 0, At, B0); PG8_BAR; PG8_SCHED;
            PG8_STAGE(PG8_SB(0, 1), b2 + hstepB, voffB);
            PG8_WAIT_V(6); PG8_BAR; PG8_MMA(1, 1, At, B1); PG8_BAR;
            PG8_LDB(B0, 1, 0); PG8_SCHED; PG8_LDA(At, 1, 0); PG8_STAGE(PG8_SA(0, 1), a2 + hstepA, voffA);
            PG8_WAIT_L(8); PG8_BAR; PG8_WAIT_L(0); PG8_MMA(0, 0, At, B0); PG8_BAR; PG8_SCHED;
            PG8_LDB(B1, 1, 1); PG8_STAGE(PG8_SB(1, 0), b3, voffB);
            PG8_BAR; PG8_WAIT_L(0); PG8_MMA(0, 1, At, B1); PG8_BAR;
            PG8_LDA(At, 1, 1); PG8_STAGE(PG8_SA(1, 0), a3, voffA);
            PG8_BAR; PG8_WAIT_L(0); PG8_MMA(1, 0, At, B0); PG8_BAR; PG8_SCHED;
            PG8_STAGE(PG8_SB(1, 1), b3 + hstepB, voffB);
            PG8_WAIT_V(6); PG8_BAR; PG8_MMA(1, 1, At, B1); PG8_BAR;
            }
        }
        if constexpr (ALIGN_EPI) { if (wr == 0) PG8_BAR; }
        if constexpr (!Epi::AFTER_DRAIN) { E(acc, cur, wr, wc, fr, fq); S.done(cur); }
        if (!has_next) break;
#pragma unroll
        for (int a = 0; a < 2; ++a)
#pragma unroll
            for (int b = 0; b < 2; ++b)
#pragma unroll
                for (int m = 0; m < 4; ++m)
#pragma unroll
                    for (int n = 0; n < 2; ++n) acc[a][b][m][n] = (f32x4){0.f, 0.f, 0.f, 0.f};
        cur = nxt; cA = nA; cB = nB; ++ui;
        if constexpr (ALIGN_EPI) { if (wr == 1) PG8_BAR; }
    }
    PG8_WAIT_V(0);
    if constexpr (!ALIGN_EPI) { if (wr == 0) PG8_BAR; }
    PG8_BAR;
    if constexpr (Epi::AFTER_DRAIN) { E.fused(acc, cur, wr, wc, fr, fq, lds, wid, lane); S.done(cur); }
#undef PG8_SA
#undef PG8_UA
#undef PG8_UB
#undef PG8_SB
#undef PG8_STAGE
#undef PG8_LDA
#undef PG8_LDB
#undef PG8_MMA
#undef PG8_WAIT_V
#undef PG8_WAIT_L
#undef PG8_BAR
#undef PG8_SCHED
}
}

#include <hip/hip_bf16.h>
#include <cmath>
namespace attn_body {
using bf16=__hip_bfloat16;
using bf16x8=__attribute__((ext_vector_type(8)))short;
using s16x4=__attribute__((ext_vector_type(4)))short;
using f32x16=__attribute__((ext_vector_type(16)))float;
using u32x4=__attribute__((ext_vector_type(4)))unsigned;
constexpr int D=64,PQ=3072,PO=2048;
constexpr int NW=8,QBLK=32,QB=QBLK*NW,KVBLK=64;
constexpr int ATTN_UNIT_ROWS=QB;
__device__ __forceinline__ int crow(int r,int hi){return (r&3)+8*(r>>2)+4*hi;}
#define SBAR() __builtin_amdgcn_sched_barrier(0)
__device__ __forceinline__ void cmask(f32x16&p0,f32x16&p1,int jb,int qrel,int hi){
  const float NEG=-INFINITY; int kb=64*jb+4*hi;
  #pragma unroll
  for(int r=0;r<16;++r){int kv=kb+(r&3)+8*(r>>2); if(kv>qrel)p0[r]=NEG; if(kv+32>qrel)p1[r]=NEG;}
}

constexpr int NSLOT=3, SLOTB=8192;
constexpr int LDS_K=0, LDS_V=NSLOT*SLOTB, LDS_WS=3*NSLOT*SLOTB, LDS_OST=LDS_WS+NW*64*4, LDS_BYTES=LDS_OST+NW*4096;
constexpr float C2=0.125f*1.4426950408889634f;
__device__ __forceinline__ void glds16(const void*gsrc,unsigned lds_dst){unsigned keep;
  asm volatile("s_mov_b32 %0, m0\n\ts_mov_b32 m0, %2\n\ts_nop 0\n\tglobal_load_lds_dwordx4 %1, off\n\ts_mov_b32 m0, %0":"=&s"(keep):"v"(gsrc),"s"(lds_dst):"memory");}
__device__ __forceinline__ float max3f(float a,float b,float c){float r;asm("v_max3_f32 %0, %1, %2, %3":"=v"(r):"v"(a),"v"(b),"v"(c));return r;}
__device__ __forceinline__ float max2f(float a,float b){float r;asm("v_max_f32_e32 %0, %1, %2":"=v"(r):"v"(a),"v"(b));return r;}
__device__ __forceinline__ float fadd_s(float a,float b){float r;asm("v_add_f32_e32 %0, %1, %2":"=v"(r):"v"(a),"v"(b));return r;}
__device__ __forceinline__ float fsub_s(float a,float b){float r;asm("v_sub_f32_e32 %0, %1, %2":"=v"(r):"v"(a),"v"(b));return r;}
typedef float f32x2_t __attribute__((ext_vector_type(2))); typedef __bf16 bf16x2_t __attribute__((ext_vector_type(2)));
__device__ __forceinline__ unsigned cvtpk_s(float lo,float hi){f32x2_t v={lo,hi};bf16x2_t b=__builtin_convertvector(v,bf16x2_t);return __builtin_bit_cast(unsigned,b);}
#define WAIT_BAR(N) asm volatile("s_waitcnt vmcnt(" #N ") lgkmcnt(0)\n\ts_barrier":::"memory")

__device__ __forceinline__ void qkt(f32x16&p0,f32x16&p1,const char*Kslot,const bf16x8*qr,const f32x16&negm,int r32,int hi){
  const char*kb=Kslot+hi*1024+r32*16;
  #pragma unroll
  for(int d0=0;d0<4;++d0){
    const bf16x8 b0=*reinterpret_cast<const bf16x8*>(kb+d0*2048);
    const bf16x8 b1=*reinterpret_cast<const bf16x8*>(kb+d0*2048+512);
    if(d0==0){p0=__builtin_amdgcn_mfma_f32_32x32x16_bf16(b0,qr[0],negm,0,0,0);p1=__builtin_amdgcn_mfma_f32_32x32x16_bf16(b1,qr[0],negm,0,0,0);}
    else{p0=__builtin_amdgcn_mfma_f32_32x32x16_bf16(b0,qr[d0],p0,0,0,0);p1=__builtin_amdgcn_mfma_f32_32x32x16_bf16(b1,qr[d0],p1,0,0,0);}}
}
typedef __attribute__((address_space(3))) const char* lds_cptr;
typedef short v4i16_t __attribute__((ext_vector_type(4)));
__device__ __forceinline__ void kload8(bf16x8*kf,lds_cptr kp){
  kf[0]=*(const __attribute__((address_space(3))) bf16x8*)(kp);      kf[1]=*(const __attribute__((address_space(3))) bf16x8*)(kp+512);
  kf[2]=*(const __attribute__((address_space(3))) bf16x8*)(kp+2048); kf[3]=*(const __attribute__((address_space(3))) bf16x8*)(kp+2560);
  kf[4]=*(const __attribute__((address_space(3))) bf16x8*)(kp+4096); kf[5]=*(const __attribute__((address_space(3))) bf16x8*)(kp+4608);
  kf[6]=*(const __attribute__((address_space(3))) bf16x8*)(kp+6144); kf[7]=*(const __attribute__((address_space(3))) bf16x8*)(kp+6656);
}
__device__ __forceinline__ void kload2(bf16x8*kf,lds_cptr kp,int j){ kf[2*j]=*(const __attribute__((address_space(3))) bf16x8*)(kp+j*2048); kf[2*j+1]=*(const __attribute__((address_space(3))) bf16x8*)(kp+j*2048+512); }
__device__ __forceinline__ s16x4 vtr(lds_cptr p){ return __builtin_bit_cast(s16x4,__builtin_amdgcn_ds_read_tr16_b64_v4i16((__attribute__((address_space(3))) v4i16_t*)p)); }
__device__ __forceinline__ float rowmax(const f32x16&p0,const f32x16&p1){
  float a=max3f(p0[0],p0[1],p1[0]),b=max3f(p0[2],p0[3],p1[1]);a=max3f(a,p1[2],p1[3]);
  #pragma unroll
  for(int r=4;r<16;r+=4){a=max3f(a,p0[r],p0[r+1]);b=max3f(b,p0[r+2],p0[r+3]);a=max3f(a,p1[r],p1[r+1]);b=max3f(b,p1[r+2],p1[r+3]);}
  const float m=max2f(a,b);
  auto rr=__builtin_amdgcn_permlane32_swap(__float_as_uint(m),__float_as_uint(m),false,false);
  return max2f(__uint_as_float(rr[0]),__uint_as_float(rr[1]));
}
__device__ __forceinline__ void pv(f32x16*o,int vb,bf16x8 pa0,bf16x8 pa1,bf16x8 pa2,bf16x8 pa3){
  #pragma unroll
  for(int d0=0;d0<2;++d0){s16x4 lo[4],hi[4];
    #pragma unroll
    for(int ks=0;ks<4;++ks){
      asm volatile("ds_read_b64_tr_b16 %0,%1 offset:%c2":"=&v"(lo[ks]):"v"(vb),"i"(d0*4096+ks*1024):"memory");
      asm volatile("ds_read_b64_tr_b16 %0,%1 offset:%c2":"=&v"(hi[ks]):"v"(vb),"i"(d0*4096+ks*1024+512):"memory");}
    asm volatile("s_waitcnt lgkmcnt(0)":::"memory");SBAR();
    #define PK(k) (bf16x8){lo[k][0],lo[k][1],lo[k][2],lo[k][3],hi[k][0],hi[k][1],hi[k][2],hi[k][3]}
    o[d0]=__builtin_amdgcn_mfma_f32_32x32x16_bf16(pa0,PK(0),o[d0],0,0,0);
    o[d0]=__builtin_amdgcn_mfma_f32_32x32x16_bf16(pa1,PK(1),o[d0],0,0,0);
    o[d0]=__builtin_amdgcn_mfma_f32_32x32x16_bf16(pa2,PK(2),o[d0],0,0,0);
    o[d0]=__builtin_amdgcn_mfma_f32_32x32x16_bf16(pa3,PK(3),o[d0],0,0,0);
    #undef PK
  }
}

#ifndef ATTN_STORE16
#define ATTN_STORE16(p,v) (*(u32x4*)(p)=(v))
#endif
template<int THRL> __device__ __forceinline__ void attn_unit(int qb,int lvalid,const bf16*Q,const bf16*__restrict__ Kh,const bf16*__restrict__ Vh,bf16*O,char*shm){
  int tid_=threadIdx.x; asm volatile("":"+v"(tid_)); const int tid=tid_,lane=tid&63,r32=lane&31,hi=lane>>5; const int wid=__builtin_amdgcn_readfirstlane(tid>>6);
  const int q0=qb*QB;
  const bf16*Qw=Q+(long)(q0+wid*QBLK)*PQ;
  const unsigned lds0=(unsigned)(uintptr_t)shm;
  float*wsf=(float*)(shm+LDS_WS)+wid*64;
  const bf16*ksrc=Kh+(long)lane*PQ+wid*8;
  const bf16*vsrc=Vh+(long)(16*(wid&3)+(lane>>2))*PQ+(wid>>2)*32+(lane&3)*8;
  const unsigned kdst=lds0+LDS_K+wid*1024, vdst=lds0+LDS_V+wid*1024;
  #define DMA_K(t,slot) glds16(ksrc+(long)(t)*KVBLK*PQ,(unsigned)__builtin_amdgcn_readfirstlane(kdst+(slot)))
  #define DMA_V(t,slot) do{ glds16(vsrc+(long)(t)*KVBLK*PQ,(unsigned)__builtin_amdgcn_readfirstlane(vdst+2*(slot))); glds16(vsrc+(long)(t)*KVBLK*PQ+64,(unsigned)__builtin_amdgcn_readfirstlane(vdst+2*(slot)+8192)); }while(0)
  const int vb0=(int)(lds0+LDS_V)+((lane>>4)&1)*32+(lane&3)*8+(4*hi+((lane&15)>>2))*64;
  const char*Kbase=shm+LDS_K; bf16x8 kf[8];
  const lds_cptr shm3=(lds_cptr)shm; const lds_cptr kp0=shm3+LDS_K+hi*1024+r32*16; const lds_cptr vp0=shm3+LDS_V+((lane>>4)&1)*32+(lane&3)*8+(4*hi+((lane&15)>>2))*64;
  const int NT=(q0+QB)/KVBLK;
  DMA_K(0,0);DMA_V(0,0);DMA_K(1,SLOTB);
  bf16x8 qr[4];
  #pragma unroll
  for(int d0=0;d0<4;++d0)qr[d0]=*reinterpret_cast<const bf16x8*>(&Qw[(long)r32*PQ+d0*16+hi*8]);
  float mhat=0.f,l_reg=0.f;f32x16 o[4];o[0]=f32x16{};o[1]=f32x16{};o[2]=f32x16{};o[3]=f32x16{};f32x16 negm=f32x16{};asm volatile("":"+v"(negm));
  const int qrel=wid*QBLK+r32;
  #define CMASK(P0,P1,t) do{int jb_=(t)-(NT-4); if(jb_>=0)cmask(P0,P1,jb_,qrel,hi);}while(0)
  bool resc=false;
  #define START(P0,P1) do{ const float rm=rowmax(P0,P1); resc=false; \
    { const float dl=rm; mhat=fadd_s(mhat,dl); \
      _Pragma("unroll") for(int r=0;r<16;++r){P0[r]=fsub_s(P0[r],dl);P1[r]=fsub_s(P1[r],dl);} \
      _Pragma("unroll") for(int r=0;r<16;++r)negm[r]=-mhat; asm volatile("":"+v"(negm)); } \
    _Pragma("unroll") for(int r=0;r<16;++r)P0[r]=__builtin_amdgcn_exp2f(P0[r]); }while(0)
  #define RESC() do{ if(resc){ asm volatile("s_waitcnt lgkmcnt(0)":::"memory"); \
      _Pragma("unroll") for(int d_=0;d_<4;++d_) _Pragma("unroll") for(int r=0;r<16;++r)o[d_][r]*=wsf[crow(r,hi)]; } }while(0)
  f32x16 pA0,pA1,pB0,pB1;
  int sl_prev=0,sl_cur=0,sl_next=SLOTB;
  #define ROT() do{sl_prev=sl_cur;sl_cur=sl_next;sl_next=(sl_next==(NSLOT-1)*SLOTB)?0:sl_next+SLOTB;}while(0)
  DMA_K(2,2*SLOTB);
  WAIT_BAR(4);
  qkt(pA0,pA1,Kbase,qr,negm,r32,hi);asm volatile("s_nop 15\n\ts_nop 7":"+v"(pA0),"+v"(pA1));CMASK(pA0,pA1,0);
  START(pA0,pA1);
  _Pragma("unroll") for(int r=0;r<16;++r)pA1[r]=__builtin_amdgcn_exp2f(pA1[r]);
  WAIT_BAR(0);
  DMA_K(3,0);DMA_V(1,SLOTB);
  ROT();
  kload8(kf,kp0+sl_cur);
  WAIT_BAR(3);
  s16x4 vlo[8],vhi[8]; u32x4 pw0,pw1,pw2,pw3;
  #define PKW(P,B) cvtpk_s(P[B],P[B+1])
  #define PAF(k) __builtin_bit_cast(bf16x8,pw##k)
  #define VFR(i) (bf16x8){vlo[i][0],vlo[i][1],vlo[i][2],vlo[i][3],vhi[i][0],vhi[i][1],vhi[i][2],vhi[i][3]}
  #define PIN(x) asm volatile("":"+v"(x))
  #define MX3(a,b,c) __builtin_fmaxf(__builtin_fmaxf((a),(b)),(c))
  #define GAPA(MF,A0,A1,A2,A3,W0,W1,PW) do{ MF; sacc+=A0; sacc+=A1; sacc+=A2; sacc+=A3; PIN(sacc); W0; W1; PIN(PW); SBAR(); }while(0)
  #define EX(v) __builtin_amdgcn_exp2f(v)
  #define GAPB(MF,X,B) do{ MF; X[B]=EX(X[B]); X[B+1]=EX(X[B+1]); X[B+2]=EX(X[B+2]); X[B+3]=EX(X[B+3]); PIN(X); SBAR(); }while(0)
  #define VRD(i) do{ vlo[i]=vtr(vp_+(((i)>>2)*4096+((i)&3)*1024)); vhi[i]=vtr(vp_+(((i)>>2)*4096+((i)&3)*1024+512)); }while(0)
  #define VRD2(i) do{ vlo[i]=vtr(vp_+(8192+((i)>>2)*4096+((i)&3)*1024)); vhi[i]=vtr(vp_+(8192+((i)>>2)*4096+((i)&3)*1024+512)); SBAR(); }while(0)
  #define GAPB2(MF,X,B) do{ MF; X[B]=EX(X[B]); X[B+1]=EX(X[B+1]); PIN(X); SBAR(); }while(0)
  #define KRD(G,j) do{ if(G){ kload2(kf,kp0+sl_next,j); SBAR(); } }while(0)
  #define STEP(C0,C1,P0,P1,t,GK,GV,GL) do{ SBAR(); \
    const lds_cptr vp_=vp0+2*sl_prev; \
    VRD(0); SBAR(); float sacc=(P0[0]+P0[1]); \
    GAPA(C0=__builtin_amdgcn_mfma_f32_32x32x16_bf16(kf[0],qr[0],negm,0,0,0), P0[2],P0[3],P0[4],P0[5],     pw0[0]=PKW(P0,0), pw0[1]=PKW(P0,2), pw0); \
    VRD(4); SBAR(); GAPA(C1=__builtin_amdgcn_mfma_f32_32x32x16_bf16(kf[1],qr[0],negm,0,0,0), P0[6],P0[7],P0[8],P0[9],     pw0[2]=PKW(P0,4), pw0[3]=PKW(P0,6), pw0); \
    VRD(1); SBAR(); GAPA(C0=__builtin_amdgcn_mfma_f32_32x32x16_bf16(kf[2],qr[1],C0,0,0,0),   P0[10],P0[11],P0[12],P0[13], pw1[0]=PKW(P0,8), pw1[1]=PKW(P0,10), pw1); \
    VRD(5); SBAR(); GAPA(C1=__builtin_amdgcn_mfma_f32_32x32x16_bf16(kf[3],qr[1],C1,0,0,0),   P0[14],P0[15],P1[0],P1[1],   pw1[2]=PKW(P0,12),pw1[3]=PKW(P0,14), pw1); \
    VRD(2); SBAR(); GAPA(C0=__builtin_amdgcn_mfma_f32_32x32x16_bf16(kf[4],qr[2],C0,0,0,0),   P1[2],P1[3],P1[4],P1[5],     pw2[0]=PKW(P1,0), pw2[1]=PKW(P1,2), pw2); \
    VRD(6); SBAR(); GAPA(C1=__builtin_amdgcn_mfma_f32_32x32x16_bf16(kf[5],qr[2],C1,0,0,0),   P1[6],P1[7],P1[8],P1[9],     pw2[2]=PKW(P1,4), pw2[3]=PKW(P1,6), pw2); \
    VRD(3); SBAR(); GAPA(C0=__builtin_amdgcn_mfma_f32_32x32x16_bf16(kf[6],qr[3],C0,0,0,0),   P1[10],P1[11],P1[12],P1[13], pw3[0]=PKW(P1,8), pw3[1]=PKW(P1,10), pw3); \
    VRD(7); SBAR(); GAPA(C1=__builtin_amdgcn_mfma_f32_32x32x16_bf16(kf[7],qr[3],C1,0,0,0),   P1[14],P1[15],0.f,0.f,       pw3[2]=PKW(P1,12),pw3[3]=PKW(P1,14), pw3); \
    l_reg+=sacc; \
    if(GK){DMA_K((t)+3,sl_cur);} if(GV){DMA_V((t)+1,sl_next);} \
    CMASK(C0,C1,t); \
    { float a=MX3(C0[0],C0[1],C1[0]),b=MX3(C0[2],C0[3],C1[1]); a=MX3(a,C1[2],C1[3]); \
      _Pragma("unroll") for(int r=4;r<16;r+=4){a=MX3(a,C0[r],C0[r+1]);b=MX3(b,C0[r+2],C0[r+3]);a=MX3(a,C1[r],C1[r+1]);b=MX3(b,C1[r+2],C1[r+3]);} \
      float rm=__builtin_fmaxf(a,b); { auto rr=__builtin_amdgcn_permlane32_swap(__float_as_uint(rm),__float_as_uint(rm),false,false); rm=__builtin_fmaxf(__uint_as_float(rr[0]),__uint_as_float(rr[1])); } \
      resc=false; \
      if(__builtin_expect(__any(rm>(float)THRL),0)){ const float dl=__builtin_fmaxf(rm,0.f); mhat+=dl; \
        _Pragma("unroll") for(int r=0;r<16;++r){C0[r]-=dl;C1[r]-=dl;} \
        _Pragma("unroll") for(int r=0;r<16;++r)negm[r]=-mhat; asm volatile("":"+v"(negm)); \
        const float f=__builtin_amdgcn_exp2f(-dl); l_reg*=f; if(hi==0)wsf[r32]=f; resc=true; } } \
    SBAR(); \
    GAPB2(o[0]=__builtin_amdgcn_mfma_f32_32x32x16_bf16(PAF(0),VFR(0),o[0],0,0,0), C0,0); \
    GAPB2(o[1]=__builtin_amdgcn_mfma_f32_32x32x16_bf16(PAF(0),VFR(4),o[1],0,0,0), C0,2); VRD2(0); VRD2(4); \
    KRD(GL,0); GAPB2(o[0]=__builtin_amdgcn_mfma_f32_32x32x16_bf16(PAF(1),VFR(1),o[0],0,0,0), C0,4); \
    KRD(GL,1); GAPB2(o[1]=__builtin_amdgcn_mfma_f32_32x32x16_bf16(PAF(1),VFR(5),o[1],0,0,0), C0,6); VRD2(1); VRD2(5); \
    GAPB2(o[2]=__builtin_amdgcn_mfma_f32_32x32x16_bf16(PAF(0),VFR(0),o[2],0,0,0), C0,8); \
    GAPB2(o[3]=__builtin_amdgcn_mfma_f32_32x32x16_bf16(PAF(0),VFR(4),o[3],0,0,0), C0,10); \
    KRD(GL,2); GAPB2(o[0]=__builtin_amdgcn_mfma_f32_32x32x16_bf16(PAF(2),VFR(2),o[0],0,0,0), C0,12); \
    KRD(GL,3); GAPB2(o[1]=__builtin_amdgcn_mfma_f32_32x32x16_bf16(PAF(2),VFR(6),o[1],0,0,0), C0,14); VRD2(2); VRD2(6); \
    GAPB2(o[2]=__builtin_amdgcn_mfma_f32_32x32x16_bf16(PAF(1),VFR(1),o[2],0,0,0), C1,0); \
    GAPB2(o[3]=__builtin_amdgcn_mfma_f32_32x32x16_bf16(PAF(1),VFR(5),o[3],0,0,0), C1,2); \
    GAPB2(o[0]=__builtin_amdgcn_mfma_f32_32x32x16_bf16(PAF(3),VFR(3),o[0],0,0,0), C1,4); \
    GAPB2(o[1]=__builtin_amdgcn_mfma_f32_32x32x16_bf16(PAF(3),VFR(7),o[1],0,0,0), C1,6); VRD2(3); VRD2(7); \
    GAPB2(o[2]=__builtin_amdgcn_mfma_f32_32x32x16_bf16(PAF(2),VFR(2),o[2],0,0,0), C1,8); \
    GAPB2(o[3]=__builtin_amdgcn_mfma_f32_32x32x16_bf16(PAF(2),VFR(6),o[3],0,0,0), C1,10); \
    GAPB2(o[2]=__builtin_amdgcn_mfma_f32_32x32x16_bf16(PAF(3),VFR(3),o[2],0,0,0), C1,12); \
    GAPB2(o[3]=__builtin_amdgcn_mfma_f32_32x32x16_bf16(PAF(3),VFR(7),o[3],0,0,0), C1,14); \
    }while(0)
  int t=1;
  #undef CMASK
  #define CMASK(P0,P1,t) do{}while(0)
  for(;t+5<NT;t+=2){
    STEP(pB0,pB1,pA0,pA1,t,true,true,true);     WAIT_BAR(3); RESC(); ROT();
    STEP(pA0,pA1,pB0,pB1,t+1,true,true,true);   WAIT_BAR(3); RESC(); ROT();
  }
  #undef CMASK
  #define CMASK(P0,P1,t) do{int jb_=(t)-(NT-4); if(jb_>=0)cmask(P0,P1,jb_,qrel,hi);}while(0)
  #define ENDW(tt) do{ if((tt)+3<NT){WAIT_BAR(3);} else if((tt)+2<NT){WAIT_BAR(2);} else {WAIT_BAR(0);} }while(0)
  for(;t+1<NT;t+=2){
    STEP(pB0,pB1,pA0,pA1,t,(t+3<NT),(t+1<NT),(t+1<NT));       ENDW(t);   RESC(); ROT();
    STEP(pA0,pA1,pB0,pB1,t+1,(t+4<NT),(t+2<NT),(t+2<NT));     ENDW(t+1); RESC(); ROT();
  }
  STEP(pB0,pB1,pA0,pA1,NT-1,false,false,false); RESC();
  { float sacc=pB0[0]+pB0[1]; _Pragma("unroll") for(int r=2;r<16;++r)sacc+=pB0[r]; _Pragma("unroll") for(int r=0;r<16;++r)sacc+=pB1[r]; l_reg+=sacc;
    pw0=(u32x4){PKW(pB0,0),PKW(pB0,2),PKW(pB0,4),PKW(pB0,6)};pw1=(u32x4){PKW(pB0,8),PKW(pB0,10),PKW(pB0,12),PKW(pB0,14)};pw2=(u32x4){PKW(pB1,0),PKW(pB1,2),PKW(pB1,4),PKW(pB1,6)};pw3=(u32x4){PKW(pB1,8),PKW(pB1,10),PKW(pB1,12),PKW(pB1,14)};
    SBAR(); pv(o,vb0+2*sl_cur,PAF(0),PAF(1),PAF(2),PAF(3)); pv(o+2,vb0+2*sl_cur+8192,PAF(0),PAF(1),PAF(2),PAF(3)); }
  #undef PKW
  #undef PAF
  #undef VFR
  #undef PIN
  #undef MX3
  #undef GAPA
  #undef GAPB
  #undef EX
  #undef VRD
  #undef KRD
  #undef STEP
  #undef ENDW
  {auto rr=__builtin_amdgcn_permlane32_swap(__float_as_uint(l_reg),__float_as_uint(l_reg),false,false);l_reg=__uint_as_float(rr[0])+__uint_as_float(rr[1]);}
  if(hi==0)wsf[32+r32]=l_reg;asm volatile("s_waitcnt lgkmcnt(0)":::"memory");
  float rli[16];
  #pragma unroll
  for(int r=0;r<16;++r)rli[r]=__builtin_amdgcn_rcpf(wsf[32+crow(r,hi)]);
  bf16*Ow=O+(long)(q0+wid*QBLK)*PO;
  { bf16*stg=(bf16*)(shm+LDS_OST)+wid*2048;
    #pragma unroll
    for(int hf=0;hf<2;++hf){
      #pragma unroll
      for(int r=0;r<16;++r){const int orow=crow(r,hi);
        #pragma unroll
        for(int d0=0;d0<2;++d0)stg[orow*64+d0*32+r32]=__float2bfloat16(o[2*hf+d0][r]*rli[r]);}
      asm volatile("s_waitcnt lgkmcnt(0)":::"memory");
      #pragma unroll
      for(int i=0;i<4;++i){const int row=i*8+(lane>>3),ch=lane&7; const u32x4 v=*(const u32x4*)(stg+row*64+ch*8); if(q0+wid*QBLK+row<lvalid)ATTN_STORE16(Ow+(long)row*PO+hf*64+ch*8,v);}
      asm volatile("s_waitcnt lgkmcnt(0)":::"memory");
    } }
  asm volatile("s_waitcnt lgkmcnt(0)\n\ts_barrier":::"memory");
  #undef DMA_K
  #undef DMA_V
  #undef CMASK
  #undef START
  #undef RESC
  #undef ROT
}
constexpr int ATTN_LDS_BYTES=LDS_BYTES;
__device__ __forceinline__ int deal_qb(int s,int i){ return (i==0)?32-s:(i==1)?17+s:(i==2)?16-s:(i==3)?1+s:0; }
template<int THRL=8> __device__ __forceinline__ void attn_phase(char*lds,const bf16*QKV,bf16*O,int vcu,int G,int L){
  const int s=vcu&7,n=(s==0)?5:4;
  for(int i=0;;++i){
    int c,qb;
    if(G==256){ if(i>=n)break; c=vcu>>3; qb=deal_qb(s,i); }
    else { const int j=vcu+i*G; if(j>=32*33)break; c=j/33; qb=32-(j%33); }
    const int b=c>>4,vh=c&15,m=vh>>3,h=vh&7;
    const bf16*base=QKV+(long)b*L*PQ; bf16*Ob=O+(long)b*L*PO+m*1024+h*128;
    attn_unit<THRL>(qb,L,base+h*128+m*64,base+1024+h*128+m*64,base+2048+h*128,Ob,lds);
  }
}
#undef SBAR
#undef WAIT_BAR
}

#ifndef PG8_ALIGN
#define PG8_ALIGN true
#endif
constexpr int NWAVES = 8;
#ifndef MK_PH
#define MK_PH 0xffffu
#endif
constexpr unsigned PH = MK_PH;
constexpr size_t MiB = 1u << 20;
constexpr size_t W_IN_T = 1 * MiB;
constexpr size_t W_BR_T = W_IN_T + (size_t)INC * DMODEL * 2;
constexpr size_t W_PW_T = W_BR_T + (size_t)3 * 2048 * 1024 * 2;
constexpr size_t W_O_T  = W_PW_T + (size_t)1024 * 256 * 2;
constexpr size_t W_F1_T = W_O_T + (size_t)2048 * 2048 * 2;
constexpr size_t W_F2_T = W_F1_T + (size_t)DFF * DMODEL * 2;
constexpr size_t WS_H   = W_F2_T + (size_t)DFF * DMODEL * 2;
constexpr size_t WS_V = WS_H;
constexpr size_t WS_OM = WS_H + (size_t)MP * DMODEL * 2;
constexpr size_t WS_HN  = WS_H + (size_t)MP * DMODEL * 4;
constexpr size_t WS_QKV = WS_HN + (size_t)MP * DMODEL * 2;
constexpr size_t WS_U4  = WS_QKV + (size_t)MPA * 3072 * 2;
constexpr size_t WS_G   = WS_U4 + (size_t)4 * MP * 1024 * 2;
constexpr size_t WS_END = WS_G + (size_t)MP * 6144 * 2;
constexpr size_t WS_T8 = WS_END;
constexpr size_t WS_T5 = WS_T8 + (size_t)DEPTH * 32 * DFF * 4;
constexpr size_t WS_HT = WS_T5 + (size_t)DEPTH * 32 * DMODEL * 4;
constexpr size_t WS_TEND = WS_HT + (size_t)32 * DMODEL * 4;
constexpr size_t WS_HID = WS_QKV;
static_assert(WS_HID + (size_t)MP * DFF * 2 <= WS_END, "d_ws map");
constexpr int RING_BYTES = 131072, LDS_TOTAL = 147456;
static_assert(pg8::STAGE_BYTES <= RING_BYTES && attn_body::ATTN_LDS_BYTES <= RING_BYTES, "LDS map");

#define GAS __attribute__((address_space(1)))
#define LAS __attribute__((address_space(3)))
typedef unsigned short bf16u;
typedef unsigned v4u __attribute__((ext_vector_type(4)));
typedef unsigned v2u __attribute__((ext_vector_type(2)));
typedef float f32x4 __attribute__((ext_vector_type(4)));
#define LDS_WAIT() asm volatile("s_waitcnt lgkmcnt(0)" ::: "memory")
__device__ __forceinline__ unsigned pk2(float lo, float hi) { return pg8::cvt_pk_bf16(lo, hi); }
__device__ __forceinline__ float wave_sum(float v) {
#pragma unroll
    for (int o = 1; o < 64; o <<= 1) v += __shfl_xor(v, o);
    return v;
}
typedef GAS unsigned gu32;
#define XB_TMO      128
#define XB_XCNT(j)  (256  + 64 * (j))
#define XB_XSUB(j)  (1280 + 64 * (j))
#define XB_XGEN(j)  (2304 + 64 * (j))
#define XB_TOP      3328
#define XB_TOPGEN   3392
#define XCD_BAR_WORDS 3456
#define XB_SPIN_CAP (1u << 18)

__device__ __forceinline__ unsigned xb_ld(unsigned* p)              { return __hip_atomic_load(p, __ATOMIC_RELAXED, __HIP_MEMORY_SCOPE_AGENT); }
__device__ __forceinline__ unsigned xb_add(unsigned* p, unsigned v) { return __hip_atomic_fetch_add(p, v, __ATOMIC_RELAXED, __HIP_MEMORY_SCOPE_AGENT); }
__device__ __forceinline__ unsigned xb_xcc_id() { return (unsigned)__builtin_amdgcn_s_getreg((3 << 11) | 20) & 0xFu; }
#define XB_SPIN(cond, bar) do { unsigned _sp = 0; while (cond) { __builtin_amdgcn_s_sleep(1); \
    if ((++_sp & 255u) == 0u) { if (xb_ld(&(bar)[XB_TMO])) break; if (_sp > XB_SPIN_CAP) { atomicAdd(&(bar)[XB_TMO], 1u); break; } } } } while (0)

struct XcdBarrier {
    unsigned* bar; unsigned x;
    volatile LAS unsigned* st;
};

__device__ __forceinline__ XcdBarrier xcd_barrier_post(unsigned* bar, volatile LAS unsigned* st) {
    XcdBarrier b; b.bar = bar; b.x = xb_xcc_id(); b.st = st;
    if (threadIdx.x == 0) (void)xb_add(&bar[XB_XCNT(b.x)], 1u);
    return b;
}
__device__ __forceinline__ void xcd_barrier_complete(unsigned* bar, unsigned x, unsigned& nloc, unsigned& nx) {
    const unsigned G = gridDim.x * gridDim.y * gridDim.z;
    unsigned sum, cnt, mine, sp = 0u;
    for (;;) {
        sum = 0u; cnt = 0u; mine = 0u;
#pragma unroll
        for (unsigned j = 0; j < 16; ++j) { const unsigned c = xb_ld(&bar[XB_XCNT(j)]); sum += c; cnt += (c > 0u) ? 1u : 0u; mine = (j == x) ? c : mine; }
        if (sum == G) break;
        __builtin_amdgcn_s_sleep(1);
        if ((++sp & 255u) == 0u) { if (xb_ld(&bar[XB_TMO])) break; if (sp > XB_SPIN_CAP) { atomicAdd(&bar[XB_TMO], 1u); break; } }
    }
    nloc = mine > 0u ? mine : 1u; nx = cnt > 0u ? cnt : 1u;
}

__device__ __forceinline__ void xcd_barrier(const XcdBarrier& b) {
    asm volatile("s_waitcnt vmcnt(0)" ::: "memory");
    __syncthreads();
    if (threadIdx.x == 0) {
        unsigned* bar = b.bar;
        __builtin_amdgcn_s_waitcnt(0);
        unsigned nloc = b.st[0], nx = b.st[1];
        if (nloc == 0u) { xcd_barrier_complete(bar, b.x, nloc, nx); b.st[0] = nloc; b.st[1] = nx; }
        const unsigned old = xb_add(&bar[XB_XSUB(b.x)], 1u);
        const unsigned gen = old / nloc;
        if (old + 1u == (gen + 1u) * nloc) {
            __builtin_amdgcn_fence(__ATOMIC_RELEASE, "agent");
            asm volatile("s_waitcnt vmcnt(0)" ::: "memory");
            const unsigned og = xb_add(&bar[XB_TOP], 1u);
            const unsigned tg = og / nx;
            if (og + 1u == (tg + 1u) * nx) xb_add(&bar[XB_TOPGEN], 1u);
            else XB_SPIN(xb_ld(&bar[XB_TOPGEN]) == tg, bar);
            __builtin_amdgcn_fence(__ATOMIC_ACQUIRE, "agent");
            xb_add(&bar[XB_XGEN(b.x)], 1u);
            asm volatile("s_waitcnt vmcnt(0)" ::: "memory");
        } else {
            XB_SPIN(xb_ld(&bar[XB_XGEN(b.x)]) == gen, bar);
            __builtin_amdgcn_fence(__ATOMIC_ACQUIRE, "agent");
            asm volatile("s_waitcnt vmcnt(0)" ::: "memory");
        }
    }
    __syncthreads();
}

struct Args { const float* in[24]; float* out; unsigned char* ws; };
__device__ __forceinline__ const void* argp(int i) { const __attribute__((address_space(4))) char* k = (const __attribute__((address_space(4))) char*)__builtin_amdgcn_kernarg_segment_ptr(); asm volatile("" : "+s"(k)); return *(const void* const __attribute__((address_space(4)))*)(k + 8 * i); }
#define IN(i) ((const float*)(const GAS float*)argp(i))
#define OUTP() ((float*)(GAS float*)argp(24))
#define WSP() ((unsigned char*)(GAS unsigned char*)argp(25))

__device__ __forceinline__ void transpose_item(const float* W, int K, int N, bf16u* WT, int ldwt, LAS float* scr, int item, int lane) {
    const int nblk = N / 32, kb = item / nblk, nb = item - kb * nblk, k0 = 64 * kb, n0 = 32 * nb;
    const float* src = W + (size_t)(k0 + (lane >> 5)) * N + n0 + (lane & 31);
#pragma unroll
    for (int i = 0; i < 32; ++i) scr[(2 * i + (lane >> 5)) * 33 + (lane & 31)] = __builtin_nontemporal_load(src + (size_t)(2 * i) * N);
    LDS_WAIT(); asm volatile("" ::: "memory");
    const int c = lane & 7;
#pragma unroll
    for (int j = 0; j < 4; ++j) { const int n = (lane >> 3) + 8 * j; const LAS float* s = scr + (8 * c) * 33 + n;
        v4u o; o.x = pk2(s[0 * 33], s[1 * 33]); o.y = pk2(s[2 * 33], s[3 * 33]); o.z = pk2(s[4 * 33], s[5 * 33]); o.w = pk2(s[6 * 33], s[7 * 33]);
        *(v4u*)(WT + (size_t)(n0 + n) * ldwt + k0 + 8 * c) = o; }
    LDS_WAIT(); asm volatile("" ::: "memory");
}
__device__ __forceinline__ void convert_weights(int l, LAS unsigned char* lds, int gw, int NGW, int wave, int lane) {
    LAS float* scr = (LAS float*)(lds + wave * 16384);
    constexpr int I_IN = 32 * 416, I_BR = 16 * 64, I_PW = 16, I_O = 32 * 64, I_F1 = 32 * 256, I_F2 = 128 * 64;
    constexpr int NITEMS = I_IN + 3 * I_BR + 4 * I_PW + I_O + I_F1 + I_F2;
    unsigned char* ws = WSP();
    for (int it = gw; it < NITEMS; it += NGW) {
        int r = it; const float* W; int K, N, ldwt = 0; bf16u* WT;
        if (r < I_IN) { W = IN(4) + (size_t)l * 2048 * INC; K = 2048; N = INC; WT = (bf16u*)(ws + W_IN_T); }
        else if ((r -= I_IN) < 3 * I_BR) { const int i = r / I_BR; r -= i * I_BR; W = (i == 0 ? IN(11) : i == 1 ? IN(14) : IN(16)) + (size_t)l * 1024 * 2048; K = 1024; N = 2048; WT = (bf16u*)(ws + W_BR_T) + (size_t)i * 1024; ldwt = 3072; }
        else if ((r -= 3 * I_BR) < 4 * I_PW) { const int g = r / I_PW; r -= g * I_PW;
            const float* src = IN(12) + (size_t)(l * 4 + g) * 65536 + (size_t)r * 4096 + lane * 4; const f32x4 sc = *(const f32x4*)(IN(13) + (size_t)l * 1024 + g * 256 + lane * 4);
            bf16u* dst = (bf16u*)(ws + W_PW_T) + (size_t)g * 65536 + (size_t)r * 4096 + lane * 4;
#pragma unroll
            for (int q = 0; q < 16; ++q) { const f32x4 v = *(const f32x4*)(src + q * 256) * sc; *(v2u*)(dst + q * 256) = (v2u){pk2(v.x, v.y), pk2(v.z, v.w)}; }
            continue; }
        else if ((r -= 4 * I_PW) < I_O) { W = IN(17) + (size_t)l * 2048 * 2048; K = 2048; N = 2048; WT = (bf16u*)(ws + W_O_T); }
        else if ((r -= I_O) < I_F1) { W = IN(20) + (size_t)l * 2048 * DFF; K = 2048; N = DFF; WT = (bf16u*)(ws + W_F1_T); }
        else { r -= I_F1; W = IN(21) + (size_t)l * DFF * 2048; K = DFF; N = 2048; WT = (bf16u*)(ws + W_F2_T); }
        transpose_item(W, K, N, WT, ldwt ? ldwt : K, scr, r, lane);
    }
}
template <int MODE>
__device__ __forceinline__ void ln_load(f32x4 (&v)[8], int m, int lane) {
    if (MODE == 0) { const int b = m >= LSEQ ? 1 : 0, p = m - b * LSEQ; const float* src = p < NMETA ? IN(1) + (size_t)p * DMODEL : IN(0) + ((size_t)b * SEQ + (p - NMETA)) * DMODEL;
#pragma unroll
        for (int j = 0; j < 8; ++j) v[j] = __builtin_nontemporal_load((const f32x4*)src + lane + 64 * j);
    } else if (m >= TAIL0) { const float* src = (const float*)(WSP() + WS_HT) + (size_t)(m - TAIL0) * DMODEL;
#pragma unroll
        for (int j = 0; j < 8; ++j) v[j] = ((const f32x4*)src)[lane + 64 * j];
    } else { const bf16u* src = (const bf16u*)(WSP() + WS_V) + (size_t)m * DMODEL;
#pragma unroll
        for (int j = 0; j < 8; ++j) { const v2u w = ((const v2u*)src)[lane + 64 * j]; v[j] = (f32x4){pg8::bf_lo(w.x), pg8::bf_hi(w.x), pg8::bf_lo(w.y), pg8::bf_hi(w.y)}; } }
}
__device__ __forceinline__ int ln_row(int gw, int NGW, int k) {
    if (NGW == 2048) { if (k < 8) return ((gw >> 8) << 11) + (gw & 255) + (k << 8); return (k == 8 && gw < MROWS - TAIL0) ? TAIL0 + gw : MROWS; }
    const int m = gw + k * NGW; return m < MROWS ? m : MROWS;
}
template <int MODE>
__device__ __forceinline__ void ln_pass(const float* gam, const float* bet, int gw, int NGW, int lane) {
    bf16u* hn = (bf16u*)(WSP() + WS_HN); float* ht = (float*)(WSP() + WS_HT);
    if (MODE != 2) for (int m = MROWS + gw; m < MP; m += NGW) {
#pragma unroll
        for (int j = 0; j < 8; ++j) ((v2u*)(hn + (size_t)m * DMODEL))[lane + 64 * j] = (v2u){0u, 0u}; }
    f32x4 g4[8], b4[8];
#pragma unroll
    for (int j = 0; j < 8; ++j) { g4[j] = ((const f32x4*)gam)[lane + 64 * j]; b4[j] = ((const f32x4*)bet)[lane + 64 * j]; }
    f32x4 v[8], vn[8];
    int k = 0, m = ln_row(gw, NGW, 0);
    if (m < MROWS) ln_load<MODE>(v, m, lane);
    while (m < MROWS) {
        const int mn = ln_row(gw, NGW, ++k);
        if (mn < MROWS) ln_load<MODE>(vn, mn, lane);
        const int b = m >= LSEQ ? 1 : 0, p = m - b * LSEQ;
        float s = 0.f;
#pragma unroll
        for (int j = 0; j < 8; ++j) s += (v[j].x + v[j].y) + (v[j].z + v[j].w);
        const float mean = wave_sum(s) * (1.f / DMODEL); float s2 = 0.f;
#pragma unroll
        for (int j = 0; j < 8; ++j) { v[j] = v[j] - mean; s2 += (v[j].x * v[j].x + v[j].y * v[j].y) + (v[j].z * v[j].z + v[j].w * v[j].w); }
        const float rstd = 1.f / sqrtf(wave_sum(s2) * (1.f / DMODEL) + LN_EPS);
#pragma unroll
        for (int j = 0; j < 8; ++j) {
            const f32x4 y = v[j] * rstd * g4[j] + b4[j];
            if (MODE != 2) {
                if (m >= TAIL0) ((f32x4*)(ht + (size_t)(m - TAIL0) * DMODEL))[lane + 64 * j] = y * DN_ALPHA;
                ((v2u*)(hn + (size_t)m * DMODEL))[lane + 64 * j] = (v2u){pk2(y.x, y.y), pk2(y.z, y.w)};
            } else if (p >= NMETA) __builtin_nontemporal_store(y, (f32x4*)(OUTP() + ((size_t)b * SEQ + (p - NMETA)) * DMODEL) + lane + 64 * j);
        }
#pragma unroll
        for (int j = 0; j < 8; ++j) v[j] = vn[j];
        m = mn;
    }
}
__device__ __forceinline__ void unpack8(const v4u w, float* f) {
    f[0] = pg8::bf_lo(w.x); f[1] = pg8::bf_hi(w.x); f[2] = pg8::bf_lo(w.y); f[3] = pg8::bf_hi(w.y); f[4] = pg8::bf_lo(w.z); f[5] = pg8::bf_hi(w.z); f[6] = pg8::bf_lo(w.w); f[7] = pg8::bf_hi(w.w);
}
__device__ __forceinline__ v4u pack8f(const float* f) { v4u o; o.x = pk2(f[0], f[1]); o.y = pk2(f[2], f[3]); o.z = pk2(f[4], f[5]); o.w = pk2(f[6], f[7]); return o; }
__device__ __forceinline__ v4u sel4(bool c, const v4u a, const v4u b) { v4u r; r.x = c ? a.x : b.x; r.y = c ? a.y : b.y; r.z = c ? a.z : b.z; r.w = c ? a.w : b.w; return r; }
__device__ __forceinline__ void pool_block(const bf16u* up, bf16u* yp, int p0, int w) {
    v4u x[23];
#pragma unroll
    for (int k = 0; k < 23; ++k) { x[k] = (v4u){0u, 0u, 0u, 0u}; if (k >= 16 - w && p0 + k - 15 >= 0) x[k] = *(const v4u*)(up + ((long)k - 15) * 1024); }
    float S[8];
#pragma unroll
    for (int c = 0; c < 8; ++c) S[c] = 0.f;
#pragma unroll
    for (int k = 0; k < 15; ++k) { float f8[8]; unpack8(x[k], f8);
#pragma unroll
        for (int c = 0; c < 8; ++c) S[c] += f8[c]; }
#pragma unroll
    for (int i = 0; i < 8; ++i) { float cur[8], old[8], o8[8]; unpack8(x[15 + i], cur);
        const v4u xo = sel4(w == 16, x[i], sel4(w == 8, x[i + 8], sel4(w == 4, x[i + 12], x[i + 14])));
        unpack8(xo, old);
        const int p = p0 + i; const float inv = 1.0f / (float)((p + 1 < w) ? p + 1 : w);
#pragma unroll
        for (int c = 0; c < 8; ++c) { S[c] += cur[c]; o8[c] = S[c] * inv - cur[c]; S[c] -= old[c]; }
        *(v4u*)(yp + (size_t)i * 3072) = pack8f(o8); }
}
__device__ __forceinline__ void elementwise_phase(int l, int gw, int NGW, int lane) {
    unsigned char* ws = WSP();
    const float lam_init = (l == 0) ? 0.2f : 0.3555090676f;
    const float lam = expf(wave_sum(IN(6)[l * 64 + lane] * IN(7)[l * 64 + lane])) - expf(wave_sum(IN(8)[l * 64 + lane] * IN(9)[l * 64 + lane])) + lam_init;
    const bf16u* O = (const bf16u*)(ws + WS_OM); bf16u* Y = (bf16u*)(ws + WS_QKV);
    const bf16u* UP = (const bf16u*)(ws + WS_U4); const bf16u* UC = UP + (size_t)MP * 1024; const bf16u* GB = UC + (size_t)MP * 1024; const bf16u* GC = GB + (size_t)MP * 1024;
    {
        const int hh = lane >> 3, off = (lane & 7) * 16; const float osc = 1.0f - lam_init;
        float gs[16];
#pragma unroll
        for (int k = 0; k < 16; ++k) gs[k] = IN(10)[l * 128 + off + k] * osc;
        for (int m0 = gw; m0 < MROWS; m0 += 2 * NGW) {
            v4u q[2][4];
#pragma unroll
            for (int r = 0; r < 2; ++r) { const int m = m0 + r * NGW; if (m < MROWS) { const bf16u* orow = O + (size_t)m * 2048 + hh * 128 + off;
                q[r][0] = *(const v4u*)orow; q[r][1] = *(const v4u*)(orow + 8); q[r][2] = *(const v4u*)(orow + 1024); q[r][3] = *(const v4u*)(orow + 1032); } }
#pragma unroll
            for (int r = 0; r < 2; ++r) { const int m = m0 + r * NGW; if (m < MROWS) {
                float o1[16], o2[16];
                unpack8(q[r][0], o1); unpack8(q[r][1], o1 + 8); unpack8(q[r][2], o2); unpack8(q[r][3], o2 + 8);
                float ss = 0.f;
#pragma unroll
                for (int k = 0; k < 16; ++k) { o1[k] = o1[k] - lam * o2[k]; ss += o1[k] * o1[k]; }
                ss += __shfl_xor(ss, 1); ss += __shfl_xor(ss, 2); ss += __shfl_xor(ss, 4);
                const float rstd = 1.f / sqrtf(ss * (1.f / 128.f) + RMS_EPS);
#pragma unroll
                for (int k = 0; k < 16; ++k) o1[k] = o1[k] * rstd * gs[k];
                bf16u* yrow = Y + (size_t)m * 3072 + hh * 128 + off;
                *(v4u*)yrow = pack8f(o1); *(v4u*)(yrow + 8) = pack8f(o1 + 8); } }
        }
    }
    {
        for (int it = gw; it < (MROWS / 16) * 4; it += NGW) {
            const int g = it & 3, row0 = 16 * (it >> 2) + 8 * (lane >> 5); const int b = row0 >= LSEQ ? 1 : 0, p0 = row0 - b * LSEQ;
            const bf16u* up = UP + (size_t)row0 * 1024 + g * 256 + (lane & 31) * 8; bf16u* yp = Y + (size_t)row0 * 3072 + 1024 + g * 256 + (lane & 31) * 8;
            pool_block(up, yp, p0, 2 << g);
        }
    }
    {
        const int c0 = lane * 16;
        float cw[3][16];
#pragma unroll
        for (int j = 0; j < 3; ++j)
#pragma unroll
            for (int k = 0; k < 16; ++k) cw[j][k] = IN(15)[(size_t)l * 3072 + j * 1024 + c0 + k];
        for (int m0 = gw; m0 < MROWS; m0 += 2 * NGW) {
            v4u qu[2][3][2], qg[2][3][2], qb[2][2]; int pp[2];
#pragma unroll
            for (int r = 0; r < 2; ++r) { const int m = m0 + r * NGW; if (m < MROWS) { const int b = m >= LSEQ ? 1 : 0; pp[r] = m - b * LSEQ;
#pragma unroll
                for (int j = 0; j < 3; ++j) if (pp[r] - 2 + j >= 0) { const size_t ro = (size_t)(m - 2 + j) * 1024 + c0;
                    qu[r][j][0] = *(const v4u*)(UC + ro); qu[r][j][1] = *(const v4u*)(UC + ro + 8); qg[r][j][0] = *(const v4u*)(GC + ro); qg[r][j][1] = *(const v4u*)(GC + ro + 8); }
                const size_t ro = (size_t)m * 1024 + c0; qb[r][0] = *(const v4u*)(GB + ro); qb[r][1] = *(const v4u*)(GB + ro + 8); } }
#pragma unroll
            for (int r = 0; r < 2; ++r) { const int m = m0 + r * NGW; if (m < MROWS) {
                float acc[16];
#pragma unroll
                for (int k = 0; k < 16; ++k) acc[k] = 0.f;
#pragma unroll
                for (int j = 0; j < 3; ++j) if (pp[r] - 2 + j >= 0) { float u[16], gc[16];
                    unpack8(qu[r][j][0], u); unpack8(qu[r][j][1], u + 8); unpack8(qg[r][j][0], gc); unpack8(qg[r][j][1], gc + 8);
#pragma unroll
                    for (int k = 0; k < 16; ++k) acc[k] += cw[j][k] * (gc[k] * u[k]); }
                float gb[16]; unpack8(qb[r][0], gb); unpack8(qb[r][1], gb + 8);
#pragma unroll
                for (int k = 0; k < 16; ++k) acc[k] *= gb[k];
                bf16u* yrow = Y + (size_t)m * 3072 + 2048 + c0;
                *(v4u*)yrow = pack8f(acc); *(v4u*)(yrow + 8) = pack8f(acc + 8); } }
        }
    }
}

__device__ __forceinline__ int opaque_v(int x) { asm volatile("" : "+v"(x)); return x; }
__device__ __forceinline__ int opaque_s(int x) { asm volatile("" : "+s"(x)); return x; }
typedef short bf16x8_t __attribute__((ext_vector_type(8)));
typedef float f32x16_t __attribute__((ext_vector_type(16)));
__device__ __forceinline__ void inproj_tail(int l, LAS unsigned char* lds, int bx, int G, int tid) {
    const int lane = tid & 63, w = __builtin_amdgcn_readfirstlane(tid >> 6), r32 = lane & 31, hi = lane >> 5;
    unsigned char* ws = WSP();
    const bf16u* HNp = (const bf16u*)(ws + WS_HN); const bf16u* W = (const bf16u*)(ws + W_IN_T);
    bf16u* QKVp = (bf16u*)(ws + WS_QKV); bf16u* U4p = (bf16u*)(ws + WS_U4); bf16u* Gp = (bf16u*)(ws + WS_G); const float* bgate = IN(5) + (size_t)l * 6144;
    LAS float* P = (LAS float*)lds;
    for (int cb = bx; cb < 256; cb += G) {
        const int n0 = cb * 52;
        const bf16u* A = HNp + (size_t)(TAIL0 + r32) * DMODEL + w * 256 + 8 * hi;
        const bf16u* B0 = W + (size_t)(n0 + r32) * DMODEL + w * 256 + 8 * hi; const bf16u* B1 = B0 + (size_t)32 * DMODEL;
        f32x16_t acc0 = {}, acc1 = {};
#pragma unroll 8
        for (int s = 0; s < 16; ++s) { const bf16x8_t a = *(const bf16x8_t*)(A + 16 * s), b0 = *(const bf16x8_t*)(B0 + 16 * s), b1 = *(const bf16x8_t*)(B1 + 16 * s);
            acc0 = __builtin_amdgcn_mfma_f32_32x32x16_bf16(b0, a, acc0, 0, 0, 0); acc1 = __builtin_amdgcn_mfma_f32_32x32x16_bf16(b1, a, acc1, 0, 0, 0); }
#pragma unroll
        for (int r = 0; r < 16; ++r) { P[((w * 2 + 0) * 16 + r) * 64 + lane] = acc0[r]; P[((w * 2 + 1) * 16 + r) * 64 + lane] = acc1[r]; }
        __syncthreads();
#pragma unroll
        for (int q = 0; q < 4; ++q) { const int idx = tid + 512 * q, ct = idx >> 10, r = (idx >> 6) & 15, L = idx & 63;
            float v = 0.f;
#pragma unroll
            for (int ww = 0; ww < 8; ++ww) v += P[((ww * 2 + ct) * 16 + r) * 64 + L];
            const int j = L & 31, n = n0 + 32 * ct + (r & 3) + 8 * (r >> 2) + 4 * (L >> 5);
            if (n < n0 + 52) { const int t = n >> 10; const size_t row = (size_t)(TAIL0 + j);
                if (t < 3) QKVp[row * 3072 + n] = (bf16u)(pk2(t == 0 ? v * attn_body::C2 : v, 0.f) & 0xffffu);
                else if (t < 7) U4p[(size_t)(t - 3) * MP * 1024 + row * 1024 + (n & 1023)] = (bf16u)(pk2(v, 0.f) & 0xffffu);
                else Gp[row * 6144 + (n - 7168)] = (bf16u)(pk2(pg8::sigmoid_f(v + bgate[n - 7168]), 0.f) & 0xffffu); }
        }
        __syncthreads();
    }
}
#ifndef MK_DUMP
#define MK_DUMP 0
#endif
#ifndef MK_DUMPL
#define MK_DUMPL 0
#endif
#ifndef MK_DUMPCOL
#define MK_DUMPCOL 0
#endif
__device__ __forceinline__ void dump_bf16(const bf16u* buf, int pitch, int coloff, int gw, int NGW, int lane) {
    float* out = OUTP();
    for (int r = gw; r < BATCH * SEQ; r += NGW) { const int b = r / SEQ, t = r - b * SEQ; const bf16u* src = buf + (size_t)(b * LSEQ + NMETA + t) * pitch + coloff;
#pragma unroll
        for (int j = 0; j < 4; ++j) { float f[8]; unpack8(*(const v4u*)(src + (lane + 64 * j) * 8), f); float* o = out + (size_t)r * DMODEL + (lane + 64 * j) * 8;
            *(f32x4*)o = (f32x4){f[0], f[1], f[2], f[3]}; *(f32x4*)(o + 4) = (f32x4){f[4], f[5], f[6], f[7]}; } }
}
#define PHASE_VARS \
    const int tid = opaque_v((int)threadIdx.x), lane = tid & 63, wave = __builtin_amdgcn_readfirstlane(tid >> 6); \
    const int G = opaque_s((int)gridDim.x), bx = opaque_s((int)blockIdx.x); const int vcu = (G % 8 == 0) ? (bx % 8) * (G / 8) + bx / 8 : bx; \
    const int gw = vcu * NWAVES + wave, NGW = G * NWAVES; unsigned char* ws = WSP(); LAS unsigned char* ldsp = (LAS unsigned char*)lds; \
    pg8::bf16_t* HN = (pg8::bf16_t*)(ws + WS_HN); pg8::bf16_t* QKV = (pg8::bf16_t*)(ws + WS_QKV); pg8::bf16_t* U4 = (pg8::bf16_t*)(ws + WS_U4); pg8::bf16_t* GT = (pg8::bf16_t*)(ws + WS_G); \
    pg8::bf16_t* HID = (pg8::bf16_t*)(ws + WS_HID); pg8::bf16_t* OM = (pg8::bf16_t*)(ws + WS_OM); pg8::bf16_t* VB = (pg8::bf16_t*)(ws + WS_V); float* H = (float*)(ws + WS_HT); (void)OM; (void)VB; \
    (void)tid; (void)lane; (void)wave; (void)vcu; (void)gw; (void)NGW; (void)ldsp; (void)HN; (void)QKV; (void)U4; (void)GT; (void)HID; (void)H;

#define GRID_SYNC() do { XcdBarrier bar_; bar_.bar = (unsigned*)(WSP()) + 4096; bar_.x = xb_xcc_id(); bar_.st = (volatile LAS unsigned*)((LAS unsigned char*)lds + RING_BYTES + 512); xcd_barrier(bar_); } while (0)
__global__ void __launch_bounds__(NWAVES * 64, 2) mega_fwd(Args a) {
    extern __shared__ __attribute__((aligned(16))) unsigned char lds[];
    cg::grid_group grid = cg::this_grid();
    {
        volatile LAS unsigned* st = (volatile LAS unsigned*)((LAS unsigned char*)lds + RING_BYTES + 512);
        if (threadIdx.x < 2) st[threadIdx.x] = 0u;
        if (blockIdx.x == 0) { unsigned* bw = (unsigned*)(WSP()) + 4096; for (int i = threadIdx.x; i < XCD_BAR_WORDS; i += NWAVES * 64) __hip_atomic_store(bw + i, 0u, __ATOMIC_RELAXED, __HIP_MEMORY_SCOPE_AGENT); }
        asm volatile("s_waitcnt vmcnt(0)" ::: "memory");
        __syncthreads();
        grid.sync();
        (void)xcd_barrier_post((unsigned*)(WSP()) + 4096, st);
    }
    {   PHASE_VARS
        for (int i = bx * NWAVES * 64 + tid; i < (MPA - MP) * 3072 * 2 / 16; i += G * NWAVES * 64) ((v4u*)(QKV + (size_t)MP * 3072))[i] = (v4u){0u, 0u, 0u, 0u};
        for (int i = bx * NWAVES * 64 + tid; i < (int)((WS_HT - WS_T8) / 16); i += G * NWAVES * 64) ((v4u*)(ws + WS_T8))[i] = (v4u){0u, 0u, 0u, 0u}; }
#pragma clang loop unroll(disable)
    for (int l = 0; l < DEPTH; ++l) {
        if constexpr (PH & 1u) { PHASE_VARS convert_weights(l, ldsp, gw, NGW, wave, lane); }
        if constexpr (PH & 2u) { PHASE_VARS if (l == 0) ln_pass<0>(IN(2), IN(3), gw, NGW, lane); else ln_pass<1>(IN(22) + (size_t)(l - 1) * DMODEL, IN(23) + (size_t)(l - 1) * DMODEL, gw, NGW, lane); }
        GRID_SYNC();
        if constexpr (PH & 4u) { PHASE_VARS
            pg8::Gemm g{HN, (const pg8::bf16_t*)(ws + W_IN_T), MP, INC, DMODEL, DMODEL, DMODEL, 0u, 0u, 0u, 0u, 0u}; pg8::StaticOrder S; S.init(TAIL0, INC, G, bx);
            pg8::EpiInProj E{QKV, U4, GT, IN(5) + (size_t)l * 6144, attn_body::C2};
            pg8::gemm_phase<pg8::EpiInProj, pg8::StaticOrder, PG8_ALIGN, true>(ldsp, g, S, E);
            inproj_tail(l, ldsp, bx, G, tid);
            {   pg8::Gemm gf{(const pg8::bf16_t*)(ws + W_BR_T) + 1024, (const pg8::bf16_t*)(ws + W_PW_T), DMODEL, 1024, opaque_s(256), 3072, 256, 512u, 0u, 0u, 0u, 0u}; pg8::StaticOrder SF; SF.init(DMODEL, 1024, G, bx);
                pg8::EpiStore EF{(pg8::bf16_t*)(ws + W_BR_T) + 1024, 3072};
                pg8::gemm_phase<pg8::EpiStore, pg8::StaticOrder, PG8_ALIGN, true>(ldsp, gf, SF, EF); } }
        GRID_SYNC();
        if constexpr (MK_DUMP == 1) { if (l == MK_DUMPL) { PHASE_VARS dump_bf16(GT, 6144, MK_DUMPCOL, gw, NGW, lane); return; } }
        if constexpr (MK_DUMP == 4) { if (l == MK_DUMPL) { PHASE_VARS dump_bf16(U4, 1024, MK_DUMPCOL, gw, NGW, lane); return; } }
        if constexpr (PH & 8u) { PHASE_VARS attn_body::attn_phase<8>((char*)lds, (const attn_body::bf16*)QKV, (attn_body::bf16*)OM, vcu, G, LSEQ); }
        GRID_SYNC();
        if constexpr (PH & 16u) { PHASE_VARS elementwise_phase(l, gw, NGW, lane); }
        GRID_SYNC();
        if constexpr (MK_DUMP == 2) { if (l == MK_DUMPL) { PHASE_VARS dump_bf16(QKV, 3072, MK_DUMPCOL, gw, NGW, lane); return; } }
        if constexpr (PH & 64u) { PHASE_VARS
            pg8::Gemm g{QKV, (const pg8::bf16_t*)(ws + W_BR_T), MP, DMODEL, 1024, 3072, 3072, 0u, 2048u, 2048u, 0u, 0u}; pg8::BranchOrder S; S.init(TAIL0, DMODEL, G, bx);
            pg8::EpiBranch E{GT, OM, U4};
            pg8::gemm_phase<pg8::EpiBranch, pg8::BranchOrder, PG8_ALIGN, true>(ldsp, g, S, E);
            pg8::Gemm gt{QKV + (size_t)TAIL0 * 3072, (const pg8::bf16_t*)(ws + W_BR_T), 256, DMODEL, opaque_s(256), 3072, 3072, 0u, 2048u, 2048u, 512u, 512u}; pg8::TailOrder3 T; T.init(G, bx);
            pg8::EpiTailGateAtomic ET{(float*)(ws + WS_T5) + (size_t)l * 32 * DMODEL, GT + (size_t)TAIL0 * 6144};
            pg8::gemm_phase<pg8::EpiTailGateAtomic, pg8::TailOrder3, PG8_ALIGN, true>(ldsp, gt, T, ET); }
        GRID_SYNC();
        if constexpr (MK_DUMP == 3) { if (l == MK_DUMPL) { PHASE_VARS dump_bf16(OM, 2048, 0, gw, NGW, lane); return; } }
        if constexpr (PH & 128u) { PHASE_VARS
            pg8::Gemm g{OM, (const pg8::bf16_t*)(ws + W_O_T), TAIL0, DMODEL, DMODEL, DMODEL, DMODEL, 0u, 0u, 0u, 0u, 0u}; pg8::StaticOrder S; S.init(TAIL0, DMODEL, G, bx);
            pg8::EpiResidV E{VB, HN, DN_ALPHA};
            pg8::gemm_phase<pg8::EpiResidV, pg8::StaticOrder, PG8_ALIGN, true>(ldsp, g, S, E);
            pg8::Gemm gt{OM + (size_t)TAIL0 * DMODEL, (const pg8::bf16_t*)(ws + W_O_T), 256, DMODEL, opaque_s(256), DMODEL, DMODEL, 0u, 512u, 512u, 0u, 0u}; pg8::TailOrder T; T.init(DMODEL / 256, DMODEL / 256, G, bx);
            pg8::EpiTailAtomic ET{H, DMODEL};
            {   pg8::Unit ju; if (T.next(0, ju)) {
                    const int r = tid >> 4, c = ju.br * 256 + (tid & 15) * 16; const float* tp = (const float*)(ws + WS_T5) + (size_t)l * 32 * DMODEL + (size_t)r * DMODEL + c;
                    const f32x4 t0 = *(const f32x4*)tp, t1 = *(const f32x4*)(tp + 4), t2 = *(const f32x4*)(tp + 8), t3 = *(const f32x4*)(tp + 12);
                    pg8::bf16_t* dp = OM + (size_t)(TAIL0 + r) * DMODEL + c; *(v4u*)dp = (v4u){pk2(t0.x, t0.y), pk2(t0.z, t0.w), pk2(t1.x, t1.y), pk2(t1.z, t1.w)}; *(v4u*)(dp + 8) = (v4u){pk2(t2.x, t2.y), pk2(t2.z, t2.w), pk2(t3.x, t3.y), pk2(t3.z, t3.w)}; }
                asm volatile("s_waitcnt vmcnt(0)" ::: "memory"); __syncthreads(); }
            pg8::gemm_phase<pg8::EpiTailAtomic, pg8::TailOrder, PG8_ALIGN, true>(ldsp, gt, T, ET); }
        GRID_SYNC();
        if constexpr (PH & 256u) { PHASE_VARS ln_pass<1>(IN(18) + (size_t)l * DMODEL, IN(19) + (size_t)l * DMODEL, gw, NGW, lane); }
        GRID_SYNC();
        if constexpr (PH & 512u) { PHASE_VARS
            pg8::Gemm g{HN, (const pg8::bf16_t*)(ws + W_F1_T), MP, DFF, DMODEL, DMODEL, DMODEL, 0u, 0u, 0u, 0u, 0u}; pg8::StaticOrder S; S.init(TAIL0, DFF, G, bx);
            pg8::EpiRelu2 E{HID, DFF};
            pg8::gemm_phase<pg8::EpiRelu2, pg8::StaticOrder, PG8_ALIGN, true>(ldsp, g, S, E);
            pg8::Gemm gt{HN + (size_t)TAIL0 * DMODEL, (const pg8::bf16_t*)(ws + W_F1_T), 256, DFF, opaque_s(256), DMODEL, DMODEL, 0u, 512u, 512u, 0u, 0u}; pg8::TailOrder T; T.init(DFF / 256, DMODEL / 256, G, bx);
            pg8::EpiTailAtomic ET{(float*)(ws + WS_T8) + (size_t)l * 32 * DFF, DFF};
            pg8::gemm_phase<pg8::EpiTailAtomic, pg8::TailOrder, PG8_ALIGN, true>(ldsp, gt, T, ET); }
        GRID_SYNC();
        if constexpr (PH & 1024u) { PHASE_VARS
            pg8::Gemm g{HID, (const pg8::bf16_t*)(ws + W_F2_T), TAIL0, DMODEL, DFF, DFF, DFF, 0u, 0u, 0u, 0u, 0u}; pg8::StaticOrder S; S.init(TAIL0, DMODEL, G, bx);
            pg8::EpiResidV E{VB, HN, DN_ALPHA};
            pg8::gemm_phase<pg8::EpiResidV, pg8::StaticOrder, PG8_ALIGN, true>(ldsp, g, S, E);
            pg8::Gemm gt{HID + (size_t)TAIL0 * DFF, (const pg8::bf16_t*)(ws + W_F2_T), 256, DMODEL, opaque_s(256), DFF, DFF, 0u, 512u, 512u, 0u, 0u}; pg8::TailOrder T; T.init(DMODEL / 256, DFF / 256, G, bx);
            pg8::EpiTailAtomic ET{H, DMODEL};
            {   pg8::Unit ju; if (T.next(0, ju)) {
                    const int r = tid >> 4, c = ju.br * 256 + (tid & 15) * 16; const float* tp = (const float*)(ws + WS_T8) + (size_t)l * 32 * DFF + (size_t)r * DFF + c;
                    f32x4 t0 = *(const f32x4*)tp, t1 = *(const f32x4*)(tp + 4), t2 = *(const f32x4*)(tp + 8), t3 = *(const f32x4*)(tp + 12);
#pragma unroll
                    for (int e = 0; e < 4; ++e) { t0[e] = fmaxf(t0[e], 0.f); t0[e] *= t0[e]; t1[e] = fmaxf(t1[e], 0.f); t1[e] *= t1[e]; t2[e] = fmaxf(t2[e], 0.f); t2[e] *= t2[e]; t3[e] = fmaxf(t3[e], 0.f); t3[e] *= t3[e]; }
                    pg8::bf16_t* dp = HID + (size_t)(TAIL0 + r) * DFF + c; *(v4u*)dp = (v4u){pk2(t0.x, t0.y), pk2(t0.z, t0.w), pk2(t1.x, t1.y), pk2(t1.z, t1.w)}; *(v4u*)(dp + 8) = (v4u){pk2(t2.x, t2.y), pk2(t2.z, t2.w), pk2(t3.x, t3.y), pk2(t3.z, t3.w)}; }
                asm volatile("s_waitcnt vmcnt(0)" ::: "memory"); __syncthreads(); }
            pg8::gemm_phase<pg8::EpiTailAtomic, pg8::TailOrder, PG8_ALIGN, true>(ldsp, gt, T, ET); }
        GRID_SYNC();
    }
    if constexpr (PH & 2048u) { PHASE_VARS ln_pass<2>(IN(22) + (size_t)(DEPTH - 1) * DMODEL, IN(23) + (size_t)(DEPTH - 1) * DMODEL, gw, NGW, lane); }
}

extern "C" void kernel_launch(void* const* d_in, const int* in_sizes, int n_in, void* d_out, int out_size, void* d_ws, size_t ws_size, hipStream_t stream) {
    static int grid = 0;
    if (grid == 0) {
        if (n_in != 24 || in_sizes[0] != BATCH * SEQ * DMODEL || out_size != BATCH * SEQ * DMODEL || ws_size < WS_TEND) {
            fprintf(stderr, "kernel_launch: unexpected shapes / workspace (n_in %d, in0 %d, out %d, ws %zu < %zu); nothing launched\n", n_in, n_in > 0 ? in_sizes[0] : -1, out_size, ws_size, (size_t)WS_TEND); grid = -1; return; }
        int dev = 0, cus = 0, per_cu = 0;
        if (hipGetDevice(&dev) != hipSuccess || hipDeviceGetAttribute(&cus, hipDeviceAttributeMultiprocessorCount, dev) != hipSuccess) { grid = -1; return; }
        if (hipFuncSetAttribute((const void*)mega_fwd, hipFuncAttributeMaxDynamicSharedMemorySize, LDS_TOTAL) != hipSuccess) { fprintf(stderr, "kernel_launch: hipFuncSetAttribute failed\n"); grid = -1; return; }
        if (hipOccupancyMaxActiveBlocksPerMultiprocessor(&per_cu, (const void*)mega_fwd, NWAVES * 64, LDS_TOTAL) != hipSuccess || per_cu < 1) per_cu = 1;
        (void)hipGetLastError();
        grid = cus * per_cu;
    }
    if (grid < 0) return;
    Args a{};
    for (int i = 0; i < 24; ++i) a.in[i] = (const float*)d_in[i];
    a.out = (float*)d_out; a.ws = (unsigned char*)d_ws;
    void* args[] = {&a};
    hipError_t e = hipLaunchCooperativeKernel((const void*)mega_fwd, dim3(grid), dim3(NWAVES * 64), args, LDS_TOTAL, stream);
    if (e != hipSuccess) fprintf(stderr, "kernel_launch: cooperative launch failed: %s (grid %d)\n", hipGetErrorString(e), grid);
}
```

```cpp
#include <hip/hip_runtime.h>
#include <hip/hip_cooperative_groups.h>
#include <cstdio>
#include <cstdint>
namespace cg = cooperative_groups;
constexpr int BATCH = 2, SEQ = 8192, NMETA = 16, LSEQ = SEQ + NMETA, DMODEL = 2048, DEPTH = 2;
constexpr int MROWS = BATCH * LSEQ;
constexpr int MP = 16640;
constexpr int MPA = MP + 256;
constexpr int TAIL0 = 16384;
constexpr int INC = 13312, DFF = 8192;
constexpr float LN_EPS = 1e-5f, RMS_EPS = 1e-5f;
constexpr float DN_ALPHA = 1.41421356237f;
namespace pg8 {
#define PG8_LAS __attribute__((address_space(3)))
typedef unsigned short bf16_t;
typedef short bf16x8 __attribute__((ext_vector_type(8)));
typedef float f32x4 __attribute__((ext_vector_type(4)));
typedef unsigned u32x4 __attribute__((ext_vector_type(4)));
constexpr int BM = 256, BK = 64, HALF = 128, HTB = HALF * BK * 2  , STAGE_BYTES = 8 * HTB, NXCD = 8, WGM = 8;

__host__ __device__ __forceinline__ int lds_byte(int r, int c) { const int st = (r >> 4) * 2 + (c >> 5), rr = r & 15, cc = c & 31, ob = rr * 64 + cc * 2; return st * 1024 + (ob ^ (((ob >> 9) & 1) << 5)); }
__host__ __device__ __forceinline__ void stage_rc(int b, int& R, int& C) { const int st = b / 1024, sb = b % 1024, swz = sb ^ (((sb >> 9) & 1) << 5); R = (st >> 1) * 16 + swz / 64; C = (st & 1) * 32 + (swz % 64) / 2; }
__host__ __device__ __forceinline__ int perm32(int rho) { const int n = rho >> 4, i = rho & 15; return 8 * (i >> 2) + 4 * n + (i & 3); }

struct Unit { int pm, pn, br, kc; };
struct Gemm { const bf16_t* A; const bf16_t* Bt; int M, N, K, lda, ldb; unsigned a_pn, a_br, b_br, a_kc, b_kc; };

struct StaticOrder {
    int nM, nN, nwg, G, c;
    __host__ __device__ void init(int M, int N, int G_, int c_) { nM = M / BM; nN = N / BM; nwg = nM * nN; G = G_; c = c_; }
    __host__ __device__ bool next(int i, Unit& u) const {
        const long L = (long)i * G + c; if (L >= nwg) return false;
        int wgid = (int)L; { const int q = nwg / NXCD, r = nwg % NXCD, xcd = wgid % NXCD, off = wgid / NXCD; wgid = (xcd < r ? xcd * (q + 1) : r * (q + 1) + (xcd - r) * q) + off; }
        const int nig = WGM * nN, gid = wgid / nig, fm = gid * WGM, gsz = (nM - fm) < WGM ? (nM - fm) : WGM;
        u.pm = fm + ((wgid % nig) % gsz); u.pn = (wgid % nig) / gsz; u.br = 0; u.kc = 0; return true;
    }
    __device__ __forceinline__ void a_ready(const Unit&) const {}
    __device__ __forceinline__ void done(const Unit&) const {}
};

typedef float f32x2c_t __attribute__((ext_vector_type(2))); typedef __bf16 bf16x2c_t __attribute__((ext_vector_type(2)));
__device__ __forceinline__ unsigned cvt_pk_bf16(float lo, float hi) { const f32x2c_t v = {lo, hi}; const bf16x2c_t b = __builtin_convertvector(v, bf16x2c_t); return __builtin_bit_cast(unsigned, b); }
struct BranchOrder {
    StaticOrder so;
    __host__ __device__ void init(int M, int N, int G_, int c_) { so.init(M, N, G_, c_); }
    __host__ __device__ bool next(int i, Unit& u) const { const int it = i / 3; if (!so.next(it, u)) return false; u.br = i - 3 * it; return true; }
    __device__ __forceinline__ void a_ready(const Unit&) const {}
    __device__ __forceinline__ void done(const Unit&) const {}
};
typedef float f32x2 __attribute__((ext_vector_type(2)));
__device__ __forceinline__ float bf_lo(unsigned w) { return __uint_as_float(w << 16); }
__device__ __forceinline__ float bf_hi(unsigned w) { return __uint_as_float(w & 0xffff0000u); }
__device__ __forceinline__ float sigmoid_f(float x) { return __builtin_amdgcn_rcpf(1.0f + __builtin_amdgcn_exp2f(-1.44269504089f * x)); }
__device__ __forceinline__ u32x4 pack8(const f32x4 v0, const f32x4 v1) { u32x4 w; w.x = cvt_pk_bf16(v0[0], v0[1]); w.y = cvt_pk_bf16(v0[2], v0[3]); w.z = cvt_pk_bf16(v1[0], v1[1]); w.w = cvt_pk_bf16(v1[2], v1[3]); return w; }

struct EpiInProj {
    static constexpr bool PERM = true, AFTER_DRAIN = false;
    bf16_t* QKV; bf16_t* U4; bf16_t* G; const float* bgate; float qscale;
    __device__ __forceinline__ void operator()(const f32x4 (&acc)[2][2][4][2], const Unit& u, int wr, int wc, int fr, int fq) const {
        const int row0 = u.pm * BM + wr * 64 + fr; const int colt = u.pn * BM, t = colt >> 10, cin = (colt & 1023) + wc * 32 + 8 * fq;
        if (t < 7) {
            bf16_t* base; int ldc; float sc = 1.f;
            if (t < 3) { base = QKV + t * 1024 + cin; ldc = 3072; if (t == 0) sc = qscale; }
            else { base = U4 + (size_t)(t - 3) * MP * 1024 + cin; ldc = 1024; }
#pragma unroll
            for (int ai = 0; ai < 2; ++ai)
#pragma unroll
                for (int m = 0; m < 4; ++m) { bf16_t* rowp = base + (size_t)(row0 + ai * HALF + m * 16) * ldc;
#pragma unroll
                    for (int bj = 0; bj < 2; ++bj) *(u32x4*)(rowp + bj * HALF) = pack8(acc[ai][bj][m][0] * sc, acc[ai][bj][m][1] * sc); }
        } else {
            const int gc = (t - 7) * 1024 + cin, gt = u.pn - 28, tid8 = (((wr * 4 + wc) * 64) + fq * 16 + fr) * 8; bf16_t* gb = G + ((size_t)(u.pm * 24 + gt) * 16) * 4096 + tid8;
            f32x4 bv[2][2];
#pragma unroll
            for (int bj = 0; bj < 2; ++bj)
#pragma unroll
                for (int n = 0; n < 2; ++n) bv[bj][n] = *(const f32x4*)(bgate + gc + bj * HALF + 4 * n);
#pragma unroll
            for (int ai = 0; ai < 2; ++ai)
#pragma unroll
                for (int m = 0; m < 4; ++m)
#pragma unroll
                    for (int bj = 0; bj < 2; ++bj) { f32x4 v0 = acc[ai][bj][m][0] + bv[bj][0], v1 = acc[ai][bj][m][1] + bv[bj][1];
#pragma unroll
                        for (int e = 0; e < 4; ++e) { v0[e] = sigmoid_f(v0[e]); v1[e] = sigmoid_f(v1[e]); }
                        __builtin_nontemporal_store(pack8(v0, v1), (u32x4*)(gb + (size_t)((ai * 4 + m) * 2 + bj) * 4096)); }
        }
    }
};
struct EpiRelu2 {
    static constexpr bool PERM = true, AFTER_DRAIN = false;
    bf16_t* O; int ldc;
    __device__ __forceinline__ void operator()(const f32x4 (&acc)[2][2][4][2], const Unit& u, int wr, int wc, int fr, int fq) const {
        const int row0 = u.pm * BM + wr * 64 + fr, col0 = u.pn * BM + wc * 32 + 8 * fq;
#pragma unroll
        for (int ai = 0; ai < 2; ++ai)
#pragma unroll
            for (int m = 0; m < 4; ++m) { bf16_t* rowp = O + (size_t)(row0 + ai * HALF + m * 16) * ldc + col0;
#pragma unroll
                for (int bj = 0; bj < 2; ++bj) { f32x4 v0 = acc[ai][bj][m][0], v1 = acc[ai][bj][m][1];
#pragma unroll
                    for (int e = 0; e < 4; ++e) { const float a = fmaxf(v0[e], 0.f), b = fmaxf(v1[e], 0.f); v0[e] = a * a; v1[e] = b * b; }
                    *(u32x4*)(rowp + bj * HALF) = pack8(v0, v1); } }
    }
};
struct EpiResid {
    static constexpr bool PERM = true, AFTER_DRAIN = false;
    float* H; float alpha;
    __device__ __forceinline__ void operator()(const f32x4 (&acc)[2][2][4][2], const Unit& u, int wr, int wc, int fr, int fq) const {
        const int row0 = u.pm * BM + wr * 64 + fr, col0 = u.pn * BM + wc * 32 + 8 * fq;
#pragma unroll
        for (int ai = 0; ai < 2; ++ai)
#pragma unroll
            for (int m = 0; m < 4; ++m) { float* rowp = H + (size_t)(row0 + ai * HALF + m * 16) * DMODEL + col0;
#pragma unroll
                for (int bj = 0; bj < 2; ++bj) { f32x4* p = (f32x4*)(rowp + bj * HALF); const f32x4 h0 = p[0], h1 = p[1];
                    p[0] = h0 * alpha + acc[ai][bj][m][0]; p[1] = h1 * alpha + acc[ai][bj][m][1]; }
                if (m & 1) asm volatile("" ::: "memory"); }
    }
};
struct EpiResidBf {
    static constexpr bool PERM = true, AFTER_DRAIN = false;
    float* H; const bf16_t* HNb; float alpha;
    __device__ __forceinline__ void operator()(const f32x4 (&acc)[2][2][4][2], const Unit& u, int wr, int wc, int fr, int fq) const {
        const int row0 = u.pm * BM + wr * 64 + fr, col0 = u.pn * BM + wc * 32 + 8 * fq;
#pragma unroll
        for (int ai = 0; ai < 2; ++ai)
#pragma unroll
            for (int m = 0; m < 4; ++m) { const size_t ro = (size_t)(row0 + ai * HALF + m * 16) * DMODEL + col0;
#pragma unroll
                for (int bj = 0; bj < 2; ++bj) { const u32x4 hw = *(const u32x4*)(HNb + ro + bj * HALF); f32x4* p = (f32x4*)(H + ro + bj * HALF);
                    p[0] = (f32x4){bf_lo(hw.x), bf_hi(hw.x), bf_lo(hw.y), bf_hi(hw.y)} * alpha + acc[ai][bj][m][0];
                    p[1] = (f32x4){bf_lo(hw.z), bf_hi(hw.z), bf_lo(hw.w), bf_hi(hw.w)} * alpha + acc[ai][bj][m][1]; }
                if (m & 1) asm volatile("" ::: "memory"); }
    }
};
struct EpiResidV {
    static constexpr bool PERM = true, AFTER_DRAIN = false;
    bf16_t* V; const bf16_t* HNb; float alpha;
    __device__ __forceinline__ void operator()(const f32x4 (&acc)[2][2][4][2], const Unit& u, int wr, int wc, int fr, int fq) const {
        const int row0 = u.pm * BM + wr * 64 + fr, col0 = u.pn * BM + wc * 32 + 8 * fq;
#pragma unroll
        for (int ai = 0; ai < 2; ++ai)
#pragma unroll
            for (int m = 0; m < 4; ++m) { const size_t ro = (size_t)(row0 + ai * HALF + m * 16) * DMODEL + col0;
#pragma unroll
                for (int bj = 0; bj < 2; ++bj) { const u32x4 hw = *(const u32x4*)(HNb + ro + bj * HALF);
                    const f32x4 v0 = (f32x4){bf_lo(hw.x), bf_hi(hw.x), bf_lo(hw.y), bf_hi(hw.y)} * alpha + acc[ai][bj][m][0], v1 = (f32x4){bf_lo(hw.z), bf_hi(hw.z), bf_lo(hw.w), bf_hi(hw.w)} * alpha + acc[ai][bj][m][1];
                    *(u32x4*)(V + ro + bj * HALF) = pack8(v0, v1); }
                if (m & 1) asm volatile("" ::: "memory"); }
    }
};
struct EpiBranch {
    static constexpr bool PERM = true, AFTER_DRAIN = false;
    const bf16_t* G; bf16_t* MG; bf16_t* PS;
    __device__ __forceinline__ void operator()(const f32x4 (&acc)[2][2][4][2], const Unit& u, int wr, int wc, int fr, int fq) const {
        const int row0 = u.pm * BM + wr * 64 + fr, col0 = u.pn * BM + wc * 32 + 8 * fq; const int br = u.br, tid8 = (((wr * 4 + wc) * 64) + fq * 16 + fr) * 8;
        const bf16_t* gb = G + ((size_t)(u.pm * 24 + br * 8 + u.pn) * 16) * 4096 + tid8; bf16_t* pb = PS + ((size_t)(u.pm * 8 + u.pn) * 16) * 4096 + tid8;
#pragma unroll
        for (int ai = 0; ai < 2; ++ai) {
            u32x4 gw[4][2], pw[4][2];
#pragma unroll
            for (int m = 0; m < 4; ++m)
#pragma unroll
                for (int bj = 0; bj < 2; ++bj) { const size_t so = (size_t)((ai * 4 + m) * 2 + bj) * 4096; gw[m][bj] = __builtin_nontemporal_load((const u32x4*)(gb + so)); pw[m][bj] = (u32x4){0u, 0u, 0u, 0u}; if (br > 0) pw[m][bj] = __builtin_nontemporal_load((const u32x4*)(pb + so)); }
#pragma unroll
            for (int m = 0; m < 4; ++m) { bf16_t* mp = MG + (size_t)(row0 + ai * HALF + m * 16) * DMODEL + col0;
#pragma unroll
                for (int bj = 0; bj < 2; ++bj) { const u32x4 g = gw[m][bj], p = pw[m][bj]; f32x4 v0 = acc[ai][bj][m][0], v1 = acc[ai][bj][m][1];
                    v0[0] = v0[0] * bf_lo(g.x) + bf_lo(p.x); v0[1] = v0[1] * bf_hi(g.x) + bf_hi(p.x); v0[2] = v0[2] * bf_lo(g.y) + bf_lo(p.y); v0[3] = v0[3] * bf_hi(g.y) + bf_hi(p.y);
                    v1[0] = v1[0] * bf_lo(g.z) + bf_lo(p.z); v1[1] = v1[1] * bf_hi(g.z) + bf_hi(p.z); v1[2] = v1[2] * bf_lo(g.w) + bf_lo(p.w); v1[3] = v1[3] * bf_hi(g.w) + bf_hi(p.w);
                    const u32x4 o = pack8(v0, v1);
                    if (br < 2) *(u32x4*)(pb + (size_t)((ai * 4 + m) * 2 + bj) * 4096) = o; else *(u32x4*)(mp + bj * HALF) = o; } }
            asm volatile("" ::: "memory");
        }
    }
};
struct EpiStore {
    static constexpr bool PERM = true, AFTER_DRAIN = false;
    bf16_t* Y; int ldc;
    __device__ __forceinline__ void operator()(const f32x4 (&acc)[2][2][4][2], const Unit& u, int wr, int wc, int fr, int fq) const {
        const int row0 = u.pm * BM + wr * 64 + fr, col0 = u.pn * BM + wc * 32 + 8 * fq;
#pragma unroll
        for (int ai = 0; ai < 2; ++ai)
#pragma unroll
            for (int m = 0; m < 4; ++m)
#pragma unroll
                for (int bj = 0; bj < 2; ++bj) *(u32x4*)(Y + (size_t)(row0 + ai * HALF + m * 16) * ldc + col0 + bj * HALF) = pack8(acc[ai][bj][m][0], acc[ai][bj][m][1]);
    }
};
struct EpiPool {
    static constexpr bool PERM = true, AFTER_DRAIN = false;
    bf16_t* Y; const float* scale;
    __device__ __forceinline__ void operator()(const f32x4 (&acc)[2][2][4][2], const Unit& u, int wr, int wc, int fr, int fq) const {
        const int row0 = u.pm * BM + wr * 64 + fr, col0 = u.pn * BM + wc * 32 + 8 * fq;
#pragma unroll
        for (int bj = 0; bj < 2; ++bj) { const f32x4 s0 = *(const f32x4*)(scale + col0 + bj * HALF), s1 = *(const f32x4*)(scale + col0 + bj * HALF + 4);
#pragma unroll
            for (int ai = 0; ai < 2; ++ai)
#pragma unroll
                for (int m = 0; m < 4; ++m) *(u32x4*)(Y + (size_t)(row0 + ai * HALF + m * 16) * 3072 + 1024 + col0 + bj * HALF) = pack8(acc[ai][bj][m][0] * s0, acc[ai][bj][m][1] * s1);
            asm volatile("" ::: "memory"); }
    }
};

struct TailOrder {
    int njobs, nN, G, c;
    __host__ __device__ void init(int nN_, int nK, int G_, int c_) { njobs = nN_ * nK; nN = nN_; G = G_; c = c_; }
    __host__ __device__ bool next(int i, Unit& u) const { const int j = i * G + c; if (j >= njobs) return false; u.pm = 0; u.pn = j % nN; u.br = j / nN; u.kc = 0; return true; }
    __device__ __forceinline__ void a_ready(const Unit&) const {}
    __device__ __forceinline__ void done(const Unit&) const {}
};
struct EpiTailAtomic {
    static constexpr bool PERM = true, AFTER_DRAIN = false;
    float* H; int ld;
    __device__ __forceinline__ void operator()(const f32x4 (&acc)[2][2][4][2], const Unit& u, int wr, int wc, int fr, int fq) const {
        if (wr != 0) return;
        const int col0 = u.pn * BM + wc * 32 + 8 * fq;
#pragma unroll
        for (int m = 0; m < 2; ++m) { float* rowp = H + (size_t)(m * 16 + fr) * ld + col0;
#pragma unroll
            for (int bj = 0; bj < 2; ++bj)
#pragma unroll
                for (int n = 0; n < 2; ++n)
#pragma unroll
                    for (int e = 0; e < 4; ++e) unsafeAtomicAdd(rowp + bj * HALF + 4 * n + e, acc[0][bj][m][n][e]); }
    }
};

struct TailOrder3 {
    int G, c;
    __host__ __device__ void init(int G_, int c_) { G = G_; c = c_; }
    __host__ __device__ bool next(int i, Unit& u) const { const int j = i * G + c; if (j >= 96) return false; u.pm = 0; u.pn = j & 7; u.br = (j >> 3) % 3; u.kc = j / 24; return true; }
    __device__ __forceinline__ void a_ready(const Unit&) const {}
    __device__ __forceinline__ void done(const Unit&) const {}
};
struct EpiTailGateAtomic {
    static constexpr bool PERM = true, AFTER_DRAIN = false;
    float* T; const bf16_t* Gt;
    __device__ __forceinline__ void operator()(const f32x4 (&acc)[2][2][4][2], const Unit& u, int wr, int wc, int fr, int fq) const {
        if (wr != 0) return;
        const int col0 = u.pn * BM + wc * 32 + 8 * fq;
#pragma unroll
        for (int m = 0; m < 2; ++m) { const int r = m * 16 + fr; float* rowp = T + (size_t)r * DMODEL + col0; const bf16_t* gp = Gt + (size_t)r * 6144 + u.br * 2048 + col0;
#pragma unroll
            for (int bj = 0; bj < 2; ++bj) { const u32x4 gw = *(const u32x4*)(gp + bj * HALF); const f32x4 a0 = acc[0][bj][m][0], a1 = acc[0][bj][m][1]; float* p = rowp + bj * HALF;
                unsafeAtomicAdd(p + 0, a0[0] * bf_lo(gw.x)); unsafeAtomicAdd(p + 1, a0[1] * bf_hi(gw.x)); unsafeAtomicAdd(p + 2, a0[2] * bf_lo(gw.y)); unsafeAtomicAdd(p + 3, a0[3] * bf_hi(gw.y));
                unsafeAtomicAdd(p + 4, a1[0] * bf_lo(gw.z)); unsafeAtomicAdd(p + 5, a1[1] * bf_hi(gw.z)); unsafeAtomicAdd(p + 6, a1[2] * bf_lo(gw.w)); unsafeAtomicAdd(p + 7, a1[3] * bf_hi(gw.w)); } }
    }
};
template <class Epi, class Sched, bool ALIGN_EPI = false, bool SP2 = false>
__device__ __forceinline__ void gemm_phase(PG8_LAS unsigned char* lds, const Gemm g, const Sched& S, const Epi& E) {
    int tid_ = threadIdx.x; asm volatile("" : "+v"(tid_)); const int tid = tid_, wid = __builtin_amdgcn_readfirstlane(tid >> 6), lane = tid & 63, wr = wid >> 2, wc = wid & 3, fr = lane & 15, fq = lane >> 4;
    const int K = g.K, nt = K / BK;
    unsigned voffA[2], voffB[2];
#pragma unroll
    for (int i = 0; i < 2; ++i) { int R, C; stage_rc(tid * 16 + i * 8192, R, C); const int Rb = Epi::PERM ? ((R & ~31) + perm32(R & 31)) : R;
        voffA[i] = (unsigned)(R * g.lda + C) * 2u; voffB[i] = (unsigned)(Rb * g.ldb + C) * 2u; }
    const size_t kstep = (size_t)(BK * 2);
    const size_t hstepA = (size_t)HALF * g.lda * 2, hstepB = (size_t)HALF * g.ldb * 2;
    const size_t tstepA = 2 * hstepA, tstepB = 2 * hstepB;
#define PG8_UA(u) ((const char*)g.A + (size_t)(u).pm * tstepA + (size_t)(u).pn * g.a_pn + (size_t)(u).br * g.a_br + (size_t)(u).kc * g.a_kc)
#define PG8_UB(u) ((const char*)g.Bt + (size_t)(u).pn * tstepB + (size_t)(u).br * g.b_br + (size_t)(u).kc * g.b_kc)
    const unsigned ldsw = (unsigned)wid * 1024u;
    const int aoff = lds_byte(wr * 64 + fr, fq * 8), boff = lds_byte(wc * 32 + fr, fq * 8);
#define PG8_SA(b, h) (((b) * 2 + (h)) * HTB)
#define PG8_SB(b, h) ((4 + (b) * 2 + (h)) * HTB)
#define PG8_STAGE(bufoff, gbase, voff) do { _Pragma("unroll") for (int _i = 0; _i < 2; ++_i) \
        __builtin_amdgcn_global_load_lds((const unsigned*)((const char*)(gbase) + (voff)[_i]), (PG8_LAS unsigned*)(lds + (bufoff) + ldsw + _i * 8192), 16, 0, 0); } while (0)
#define PG8_LDA(dst, b, h) do { _Pragma("unroll") for (int m = 0; m < 4; ++m) _Pragma("unroll") for (int k = 0; k < 2; ++k) dst[m][k] = *(const PG8_LAS bf16x8*)(lds + PG8_SA(b, h) + aoff + m * 2048 + k * 1024); } while (0)
#define PG8_LDB(dst, b, h) do { _Pragma("unroll") for (int n = 0; n < 2; ++n) _Pragma("unroll") for (int k = 0; k < 2; ++k) dst[n][k] = *(const PG8_LAS bf16x8*)(lds + PG8_SB(b, h) + boff + n * 2048 + k * 1024); } while (0)
#define PG8_MMA(ai, bj, At, Bt) do { __builtin_amdgcn_s_setprio(1); _Pragma("unroll") for (int k = 0; k < 2; ++k) _Pragma("unroll") for (int m = 0; m < 4; ++m) _Pragma("unroll") for (int n = 0; n < 2; ++n) \
        acc[ai][bj][m][n] = __builtin_amdgcn_mfma_f32_16x16x32_bf16(Bt[n][k], At[m][k], acc[ai][bj][m][n], 0, 0, 0); __builtin_amdgcn_s_setprio(0); } while (0)
#define PG8_WAIT_V(n) asm volatile("s_waitcnt vmcnt(" #n ")" ::: "memory")
#define PG8_WAIT_L(n) asm volatile("s_waitcnt lgkmcnt(" #n ")" ::: "memory")
#define PG8_BAR __builtin_amdgcn_s_barrier()
#define PG8_SCHED __builtin_amdgcn_sched_barrier(0)
    Unit cur, nxt; int ui = 0;
    if (!S.next(0, cur)) return;
    f32x4 acc[2][2][4][2];
#pragma unroll
    for (int a = 0; a < 2; ++a)
#pragma unroll
        for (int b = 0; b < 2; ++b)
#pragma unroll
            for (int m = 0; m < 4; ++m)
#pragma unroll
                for (int n = 0; n < 2; ++n) acc[a][b][m][n] = (f32x4){0.f, 0.f, 0.f, 0.f};
    bf16x8 At[4][2], B0[2][2], B1[2][2];
    const char* cA = PG8_UA(cur); const char* cB = PG8_UB(cur);
    S.a_ready(cur);
    if constexpr (SP2) {
        PG8_STAGE(PG8_SB(0, 0), cB, voffB); PG8_STAGE(PG8_SB(0, 1), cB + hstepB, voffB); PG8_STAGE(PG8_SA(0, 0), cA, voffA); PG8_STAGE(PG8_SA(0, 1), cA + hstepA, voffA);
        if (wr == 1) PG8_BAR;
        PG8_WAIT_V(2); PG8_BAR;
        PG8_STAGE(PG8_SB(1, 0), cB + kstep, voffB); PG8_STAGE(PG8_SA(1, 0), cA + kstep, voffA); PG8_STAGE(PG8_SB(1, 1), cB + hstepB + kstep, voffB);
        PG8_WAIT_V(6); PG8_BAR;
    } else {
        PG8_STAGE(PG8_SB(0, 0), cB, voffB); PG8_STAGE(PG8_SA(0, 0), cA, voffA); PG8_STAGE(PG8_SB(0, 1), cB + hstepB, voffB); PG8_STAGE(PG8_SA(0, 1), cA + hstepA, voffA);
        if (wr == 1) PG8_BAR;
        PG8_WAIT_V(4); PG8_BAR;
        PG8_STAGE(PG8_SB(1, 0), cB + kstep, voffB); PG8_STAGE(PG8_SA(1, 0), cA + kstep, voffA); PG8_STAGE(PG8_SB(1, 1), cB + hstepB + kstep, voffB);
        PG8_WAIT_V(6); PG8_BAR;
    }
    for (;;) {
        const bool has_next = S.next(ui + 1, nxt);
        const char* nA = has_next ? PG8_UA(nxt) : cA; const char* nB = has_next ? PG8_UB(nxt) : cB;
        for (int t = 0; t < nt; t += 2) {
            const bool last = (t == nt - 2);
            const char* a1 = cA + (size_t)(t + 1) * kstep;
            const char* a2 = last ? nA : cA + (size_t)(t + 2) * kstep; const char* b2 = last ? nB : cB + (size_t)(t + 2) * kstep;
            const char* a3 = a2 + kstep; const char* b3 = b2 + kstep;
            if (last && has_next) S.a_ready(nxt);
            if constexpr (SP2) {
            PG8_LDB(B0, 0, 0); PG8_LDB(B1, 0, 1); PG8_SCHED; PG8_LDA(At, 0, 0); PG8_STAGE(PG8_SA(1, 1), a1 + hstepA, voffA);
            PG8_WAIT_V(8); PG8_WAIT_L(0); PG8_BAR; PG8_MMA(0, 0, At, B0); PG8_MMA(0, 1, At, B1); PG8_BAR; PG8_SCHED;
            PG8_LDA(At, 0, 1); PG8_STAGE(PG8_SB(0, 0), b2, voffB); PG8_STAGE(PG8_SB(0, 1), b2 + hstepB, voffB); PG8_STAGE(PG8_SA(0, 0), a2, voffA);
            PG8_WAIT_V(8); PG8_WAIT_L(0); PG8_BAR; PG8_MMA(1, 0, At, B0); PG8_MMA(1, 1, At, B1); PG8_BAR; PG8_SCHED;
            PG8_LDB(B0, 1, 0); PG8_LDB(B1, 1, 1); PG8_SCHED; PG8_LDA(At, 1, 0); PG8_STAGE(PG8_SA(0, 1), a2 + hstepA, voffA);
            PG8_WAIT_V(8); PG8_WAIT_L(0); PG8_BAR; PG8_MMA(0, 0, At, B0); PG8_MMA(0, 1, At, B1); PG8_BAR; PG8_SCHED;
            PG8_LDA(At, 1, 1); PG8_STAGE(PG8_SB(1, 0), b3, voffB); PG8_STAGE(PG8_SB(1, 1), b3 + hstepB, voffB); PG8_STAGE(PG8_SA(1, 0), a3, voffA);
            PG8_WAIT_V(8); PG8_WAIT_L(0); PG8_BAR; PG8_MMA(1, 0, At, B0); PG8_MMA(1, 1, At, B1); PG8_BAR; PG8_SCHED;
            } else {
            PG8_LDB(B0, 0, 0); PG8_SCHED; PG8_LDA(At, 0, 0); PG8_STAGE(PG8_SA(1, 1), a1 + hstepA, voffA);
            PG8_WAIT_L(8); PG8_BAR; PG8_WAIT_L(0); PG8_MMA(0, 0, At, B0); PG8_BAR; PG8_SCHED;
            PG8_LDB(B1, 0, 1); PG8_STAGE(PG8_SB(0, 0), b2, voffB);
            PG8_BAR; PG8_WAIT_L(0); PG8_MMA(0, 1, At, B1); PG8_BAR;
            PG8_LDA(At, 0, 1); PG8_STAGE(PG8_SA(0, 0), a2, voffA);
            PG8_BAR; PG8_WAIT_L(0); PG8_MMA(1, 0, At, B0); PG8_BAR; PG8_SCHED;
            PG8_STAGE(PG8_SB(0, 1), b2 + hstepB, voffB);
            PG8_WAIT_V(6); PG8_BAR; PG8_MMA(1, 1, At, B1); PG8_BAR;
            PG8_LDB(B0, 1, 0); PG8_SCHED; PG8_LDA(At, 1, 0); PG8_STAGE(PG8_SA(0, 1), a2 + hstepA, voffA);
            PG8_WAIT_L(8); PG8_BAR; PG8_WAIT_L(0); PG8_MMA(0, 0, At, B0); PG8_BAR; PG8_SCHED;
            PG8_LDB(B1, 1, 1); PG8_STAGE(PG8_SB(1, 0), b3, voffB);
            PG8_BAR; PG8_WAIT_L(0); PG8_MMA(0, 1, At, B1); PG8_BAR;
            PG8_LDA(At, 1, 1); PG8_STAGE(PG8_SA(1, 0), a3, voffA);
            PG8_BAR; PG8_WAIT_L(0); PG8_MMA(1, 0, At, B0); PG8_BAR; PG8_SCHED;
            PG8_STAGE(PG8_SB(1, 1), b3 + hstepB, voffB);
            PG8_WAIT_V(6); PG8_BAR; PG8_MMA(1, 1, At, B1); PG8_BAR;
            }
        }
        if constexpr (ALIGN_EPI) { if (wr == 0) PG8_BAR; }
        if constexpr (!Epi::AFTER_DRAIN) { E(acc, cur, wr, wc, fr, fq); S.done(cur); }
        if (!has_next) break;
#pragma unroll
        for (int a = 0; a < 2; ++a)
#pragma unroll
            for (int b = 0; b < 2; ++b)
#pragma unroll
                for (int m = 0; m < 4; ++m)
#pragma unroll
                    for (int n = 0; n < 2; ++n) acc[a][b][m][n] = (f32x4){0.f, 0.f, 0.f, 0.f};
        cur = nxt; cA = nA; cB = nB; ++ui;
        if constexpr (ALIGN_EPI) { if (wr == 1) PG8_BAR; }
    }
    PG8_WAIT_V(0);
    if constexpr (!ALIGN_EPI) { if (wr == 0) PG8_BAR; }
    PG8_BAR;
    if constexpr (Epi::AFTER_DRAIN) { E.fused(acc, cur, wr, wc, fr, fq, lds, wid, lane); S.done(cur); }
#undef PG8_SA
#undef PG8_UA
#undef PG8_UB
#undef PG8_SB
#undef PG8_STAGE
#undef PG8_LDA
#undef PG8_LDB
#undef PG8_MMA
#undef PG8_WAIT_V
#undef PG8_WAIT_L
#undef PG8_BAR
#undef PG8_SCHED
}
}

#include <hip/hip_bf16.h>
#include <cmath>
namespace attn_body {
using bf16=__hip_bfloat16;
using bf16x8=__attribute__((ext_vector_type(8)))short;
using s16x4=__attribute__((ext_vector_type(4)))short;
using f32x16=__attribute__((ext_vector_type(16)))float;
using u32x4=__attribute__((ext_vector_type(4)))unsigned;
constexpr int D=64,PQ=3072,PO=2048;
constexpr int NW=8,QBLK=32,QB=QBLK*NW,KVBLK=64;
constexpr int ATTN_UNIT_ROWS=QB;
__device__ __forceinline__ int crow(int r,int hi){return (r&3)+8*(r>>2)+4*hi;}
#define SBAR() __builtin_amdgcn_sched_barrier(0)
__device__ __forceinline__ void cmask(f32x16&p0,f32x16&p1,int jb,int qrel,int hi){
  const float NEG=-INFINITY; int kb=64*jb+4*hi;
  #pragma unroll
  for(int r=0;r<16;++r){int kv=kb+(r&3)+8*(r>>2); if(kv>qrel)p0[r]=NEG; if(kv+32>qrel)p1[r]=NEG;}
}

constexpr int NSLOT=3, SLOTB=8192;
constexpr int LDS_K=0, LDS_V=NSLOT*SLOTB, LDS_WS=3*NSLOT*SLOTB, LDS_OST=LDS_WS+NW*64*4, LDS_BYTES=LDS_OST+NW*4096;
constexpr float C2=0.125f*1.4426950408889634f;
__device__ __forceinline__ void glds16(const void*gsrc,unsigned lds_dst){unsigned keep;
  asm volatile("s_mov_b32 %0, m0\n\ts_mov_b32 m0, %2\n\ts_nop 0\n\tglobal_load_lds_dwordx4 %1, off\n\ts_mov_b32 m0, %0":"=&s"(keep):"v"(gsrc),"s"(lds_dst):"memory");}
__device__ __forceinline__ float max3f(float a,float b,float c){float r;asm("v_max3_f32 %0, %1, %2, %3":"=v"(r):"v"(a),"v"(b),"v"(c));return r;}
__device__ __forceinline__ float max2f(float a,float b){float r;asm("v_max_f32_e32 %0, %1, %2":"=v"(r):"v"(a),"v"(b));return r;}
__device__ __forceinline__ float fadd_s(float a,float b){float r;asm("v_add_f32_e32 %0, %1, %2":"=v"(r):"v"(a),"v"(b));return r;}
__device__ __forceinline__ float fsub_s(float a,float b){float r;asm("v_sub_f32_e32 %0, %1, %2":"=v"(r):"v"(a),"v"(b));return r;}
typedef float f32x2_t __attribute__((ext_vector_type(2))); typedef __bf16 bf16x2_t __attribute__((ext_vector_type(2)));
__device__ __forceinline__ unsigned cvtpk_s(float lo,float hi){f32x2_t v={lo,hi};bf16x2_t b=__builtin_convertvector(v,bf16x2_t);return __builtin_bit_cast(unsigned,b);}
#define WAIT_BAR(N) asm volatile("s_waitcnt vmcnt(" #N ") lgkmcnt(0)\n\ts_barrier":::"memory")

__device__ __forceinline__ void qkt(f32x16&p0,f32x16&p1,const char*Kslot,const bf16x8*qr,const f32x16&negm,int r32,int hi){
  const char*kb=Kslot+hi*1024+r32*16;
  #pragma unroll
  for(int d0=0;d0<4;++d0){
    const bf16x8 b0=*reinterpret_cast<const bf16x8*>(kb+d0*2048);
    const bf16x8 b1=*reinterpret_cast<const bf16x8*>(kb+d0*2048+512);
    if(d0==0){p0=__builtin_amdgcn_mfma_f32_32x32x16_bf16(b0,qr[0],negm,0,0,0);p1=__builtin_amdgcn_mfma_f32_32x32x16_bf16(b1,qr[0],negm,0,0,0);}
    else{p0=__builtin_amdgcn_mfma_f32_32x32x16_bf16(b0,qr[d0],p0,0,0,0);p1=__builtin_amdgcn_mfma_f32_32x32x16_bf16(b1,qr[d0],p1,0,0,0);}}
}
typedef __attribute__((address_space(3))) const char* lds_cptr;
typedef short v4i16_t __attribute__((ext_vector_type(4)));
__device__ __forceinline__ void kload8(bf16x8*kf,lds_cptr kp){
  kf[0]=*(const __attribute__((address_space(3))) bf16x8*)(kp);      kf[1]=*(const __attribute__((address_space(3))) bf16x8*)(kp+512);
  kf[2]=*(const __attribute__((address_space(3))) bf16x8*)(kp+2048); kf[3]=*(const __attribute__((address_space(3))) bf16x8*)(kp+2560);
  kf[4]=*(const __attribute__((address_space(3))) bf16x8*)(kp+4096); kf[5]=*(const __attribute__((address_space(3))) bf16x8*)(kp+4608);
  kf[6]=*(const __attribute__((address_space(3))) bf16x8*)(kp+6144); kf[7]=*(const __attribute__((address_space(3))) bf16x8*)(kp+6656);
}
__device__ __forceinline__ void kload2(bf16x8*kf,lds_cptr kp,int j){ kf[2*j]=*(const __attribute__((address_space(3))) bf16x8*)(kp+j*2048); kf[2*j+1]=*(const __attribute__((address_space(3))) bf16x8*)(kp+j*2048+512); }
__device__ __forceinline__ s16x4 vtr(lds_cptr p){ return __builtin_bit_cast(s16x4,__builtin_amdgcn_ds_read_tr16_b64_v4i16((__attribute__((address_space(3))) v4i16_t*)p)); }
__device__ __forceinline__ float rowmax(const f32x16&p0,const f32x16&p1){
  float a=max3f(p0[0],p0[1],p1[0]),b=max3f(p0[2],p0[3],p1[1]);a=max3f(a,p1[2],p1[3]);
  #pragma unroll
  for(int r=4;r<16;r+=4){a=max3f(a,p0[r],p0[r+1]);b=max3f(b,p0[r+2],p0[r+3]);a=max3f(a,p1[r],p1[r+1]);b=max3f(b,p1[r+2],p1[r+3]);}
  const float m=max2f(a,b);
  auto rr=__builtin_amdgcn_permlane32_swap(__float_as_uint(m),__float_as_uint(m),false,false);
  return max2f(__uint_as_float(rr[0]),__uint_as_float(rr[1]));
}
__device__ __forceinline__ void pv(f32x16*o,int vb,bf16x8 pa0,bf16x8 pa1,bf16x8 pa2,bf16x8 pa3){
  #pragma unroll
  for(int d0=0;d0<2;++d0){s16x4 lo[4],hi[4];
    #pragma unroll
    for(int ks=0;ks<4;++ks){
      asm volatile("ds_read_b64_tr_b16 %0,%1 offset:%c2":"=&v"(lo[ks]):"v"(vb),"i"(d0*4096+ks*1024):"memory");
      asm volatile("ds_read_b64_tr_b16 %0,%1 offset:%c2":"=&v"(hi[ks]):"v"(vb),"i"(d0*4096+ks*1024+512):"memory");}
    asm volatile("s_waitcnt lgkmcnt(0)":::"memory");SBAR();
    #define PK(k) (bf16x8){lo[k][0],lo[k][1],lo[k][2],lo[k][3],hi[k][0],hi[k][1],hi[k][2],hi[k][3]}
    o[d0]=__builtin_amdgcn_mfma_f32_32x32x16_bf16(pa0,PK(0),o[d0],0,0,0);
    o[d0]=__builtin_amdgcn_mfma_f32_32x32x16_bf16(pa1,PK(1),o[d0],0,0,0);
    o[d0]=__builtin_amdgcn_mfma_f32_32x32x16_bf16(pa2,PK(2),o[d0],0,0,0);
    o[d0]=__builtin_amdgcn_mfma_f32_32x32x16_bf16(pa3,PK(3),o[d0],0,0,0);
    #undef PK
  }
}

#ifndef ATTN_STORE16
#define ATTN_STORE16(p,v) (*(u32x4*)(p)=(v))
#endif
template<int THRL> __device__ __forceinline__ void attn_unit(int qb,int lvalid,const bf16*Q,const bf16*__restrict__ Kh,const bf16*__restrict__ Vh,bf16*O,char*shm){
  int tid_=threadIdx.x; asm volatile("":"+v"(tid_)); const int tid=tid_,lane=tid&63,r32=lane&31,hi=lane>>5; const int wid=__builtin_amdgcn_readfirstlane(tid>>6);
  const int q0=qb*QB;
  const bf16*Qw=Q+(long)(q0+wid*QBLK)*PQ;
  const unsigned lds0=(unsigned)(uintptr_t)shm;
  float*wsf=(float*)(shm+LDS_WS)+wid*64;
  const bf16*ksrc=Kh+(long)lane*PQ+wid*8;
  const bf16*vsrc=Vh+(long)(16*(wid&3)+(lane>>2))*PQ+(wid>>2)*32+(lane&3)*8;
  const unsigned kdst=lds0+LDS_K+wid*1024, vdst=lds0+LDS_V+wid*1024;
  #define DMA_K(t,slot) glds16(ksrc+(long)(t)*KVBLK*PQ,(unsigned)__builtin_amdgcn_readfirstlane(kdst+(slot)))
  #define DMA_V(t,slot) do{ glds16(vsrc+(long)(t)*KVBLK*PQ,(unsigned)__builtin_amdgcn_readfirstlane(vdst+2*(slot))); glds16(vsrc+(long)(t)*KVBLK*PQ+64,(unsigned)__builtin_amdgcn_readfirstlane(vdst+2*(slot)+8192)); }while(0)
  const int vb0=(int)(lds0+LDS_V)+((lane>>4)&1)*32+(lane&3)*8+(4*hi+((lane&15)>>2))*64;
  const char*Kbase=shm+LDS_K; bf16x8 kf[8];
  const lds_cptr shm3=(lds_cptr)shm; const lds_cptr kp0=shm3+LDS_K+hi*1024+r32*16; const lds_cptr vp0=shm3+LDS_V+((lane>>4)&1)*32+(lane&3)*8+(4*hi+((lane&15)>>2))*64;
  const int NT=(q0+QB)/KVBLK;
  DMA_K(0,0);DMA_V(0,0);DMA_K(1,SLOTB);
  bf16x8 qr[4];
  #pragma unroll
  for(int d0=0;d0<4;++d0)qr[d0]=*reinterpret_cast<const bf16x8*>(&Qw[(long)r32*PQ+d0*16+hi*8]);
  float mhat=0.f,l_reg=0.f;f32x16 o[4];o[0]=f32x16{};o[1]=f32x16{};o[2]=f32x16{};o[3]=f32x16{};f32x16 negm=f32x16{};asm volatile("":"+v"(negm));
  const int qrel=wid*QBLK+r32;
  #define CMASK(P0,P1,t) do{int jb_=(t)-(NT-4); if(jb_>=0)cmask(P0,P1,jb_,qrel,hi);}while(0)
  bool resc=false;
  #define START(P0,P1) do{ const float rm=rowmax(P0,P1); resc=false; \
    { const float dl=rm; mhat=fadd_s(mhat,dl); \
      _Pragma("unroll") for(int r=0;r<16;++r){P0[r]=fsub_s(P0[r],dl);P1[r]=fsub_s(P1[r],dl);} \
      _Pragma("unroll") for(int r=0;r<16;++r)negm[r]=-mhat; asm volatile("":"+v"(negm)); } \
    _Pragma("unroll") for(int r=0;r<16;++r)P0[r]=__builtin_amdgcn_exp2f(P0[r]); }while(0)
  #define RESC() do{ if(resc){ asm volatile("s_waitcnt lgkmcnt(0)":::"memory"); \
      _Pragma("unroll") for(int d_=0;d_<4;++d_) _Pragma("unroll") for(int r=0;r<16;++r)o[d_][r]*=wsf[crow(r,hi)]; } }while(0)
  f32x16 pA0,pA1,pB0,pB1;
  int sl_prev=0,sl_cur=0,sl_next=SLOTB;
  #define ROT() do{sl_prev=sl_cur;sl_cur=sl_next;sl_next=(sl_next==(NSLOT-1)*SLOTB)?0:sl_next+SLOTB;}while(0)
  DMA_K(2,2*SLOTB);
  WAIT_BAR(4);
  qkt(pA0,pA1,Kbase,qr,negm,r32,hi);asm volatile("s_nop 15\n\ts_nop 7":"+v"(pA0),"+v"(pA1));CMASK(pA0,pA1,0);
  START(pA0,pA1);
  _Pragma("unroll") for(int r=0;r<16;++r)pA1[r]=__builtin_amdgcn_exp2f(pA1[r]);
  WAIT_BAR(0);
  DMA_K(3,0);DMA_V(1,SLOTB);
  ROT();
  kload8(kf,kp0+sl_cur);
  WAIT_BAR(3);
  s16x4 vlo[8],vhi[8]; u32x4 pw0,pw1,pw2,pw3;
  #define PKW(P,B) cvtpk_s(P[B],P[B+1])
  #define PAF(k) __builtin_bit_cast(bf16x8,pw##k)
  #define VFR(i) (bf16x8){vlo[i][0],vlo[i][1],vlo[i][2],vlo[i][3],vhi[i][0],vhi[i][1],vhi[i][2],vhi[i][3]}
  #define PIN(x) asm volatile("":"+v"(x))
  #define MX3(a,b,c) __builtin_fmaxf(__builtin_fmaxf((a),(b)),(c))
  #define GAPA(MF,A0,A1,A2,A3,W0,W1,PW) do{ MF; sacc+=A0; sacc+=A1; sacc+=A2; sacc+=A3; PIN(sacc); W0; W1; PIN(PW); SBAR(); }while(0)
  #define EX(v) __builtin_amdgcn_exp2f(v)
  #define GAPB(MF,X,B) do{ MF; X[B]=EX(X[B]); X[B+1]=EX(X[B+1]); X[B+2]=EX(X[B+2]); X[B+3]=EX(X[B+3]); PIN(X); SBAR(); }while(0)
  #define VRD(i) do{ vlo[i]=vtr(vp_+(((i)>>2)*4096+((i)&3)*1024)); vhi[i]=vtr(vp_+(((i)>>2)*4096+((i)&3)*1024+512)); }while(0)
  #define VRD2(i) do{ vlo[i]=vtr(vp_+(8192+((i)>>2)*4096+((i)&3)*1024)); vhi[i]=vtr(vp_+(8192+((i)>>2)*4096+((i)&3)*1024+512)); SBAR(); }while(0)
  #define GAPB2(MF,X,B) do{ MF; X[B]=EX(X[B]); X[B+1]=EX(X[B+1]); PIN(X); SBAR(); }while(0)
  #define KRD(G,j) do{ if(G){ kload2(kf,kp0+sl_next,j); SBAR(); } }while(0)
  #define STEP(C0,C1,P0,P1,t,GK,GV,GL) do{ SBAR(); \
    const lds_cptr vp_=vp0+2*sl_prev; \
    VRD(0); SBAR(); float sacc=(P0[0]+P0[1]); \
    GAPA(C0=__builtin_amdgcn_mfma_f32_32x32x16_bf16(kf[0],qr[0],negm,0,0,0), P0[2],P0[3],P0[4],P0[5],     pw0[0]=PKW(P0,0), pw0[1]=PKW(P0,2), pw0); \
    VRD(4); SBAR(); GAPA(C1=__builtin_amdgcn_mfma_f32_32x32x16_bf16(kf[1],qr[0],negm,0,0,0), P0[6],P0[7],P0[8],P0[9],     pw0[2]=PKW(P0,4), pw0[3]=PKW(P0,6), pw0); \
    VRD(1); SBAR(); GAPA(C0=__builtin_amdgcn_mfma_f32_32x32x16_bf16(kf[2],qr[1],C0,0,0,0),   P0[10],P0[11],P0[12],P0[13], pw1[0]=PKW(P0,8), pw1[1]=PKW(P0,10), pw1); \
    VRD(5); SBAR(); GAPA(C1=__builtin_amdgcn_mfma_f32_32x32x16_bf16(kf[3],qr[1],C1,0,0,0),   P0[14],P0[15],P1[0],P1[1],   pw1[2]=PKW(P0,12),pw1[3]=PKW(P0,14), pw1); \
    VRD(2); SBAR(); GAPA(C0=__builtin_amdgcn_mfma_f32_32x32x16_bf16(kf[4],qr[2],C0,0,0,0),   P1[2],P1[3],P1[4],P1[5],     pw2[0]=PKW(P1,0), pw2[1]=PKW(P1,2), pw2); \
    VRD(6); SBAR(); GAPA(C1=__builtin_amdgcn_mfma_f32_32x32x16_bf16(kf[5],qr[2],C1,0,0,0),   P1[6],P1[7],P1[8],P1[9],     pw2[2]=PKW(P1,4), pw2[3]=PKW(P1,6), pw2); \
    VRD(3); SBAR(); GAPA(C0=__builtin_amdgcn_mfma_f32_32x32x16_bf16(kf[6],qr[3],C0,0,0,0),   P1[10],P1[11],P1[12],P1[13], pw3[0]=PKW(P1,8), pw3[1]=PKW(P1,10), pw3); \
    VRD(7); SBAR(); GAPA(C1=__builtin_amdgcn_mfma_f32_32x32x16_bf16(kf[7],qr[3],C1,0,0,0),   P1[14],P1[15],0.f,0.f,       pw3[2]=PKW(P1,12),pw3[3]=PKW(P1,14), pw3); \
    l_reg+=sacc; \
    if(GK){DMA_K((t)+3,sl_cur);} if(GV){DMA_V((t)+1,sl_next);} \
    CMASK(C0,C1,t); \
    { float a=MX3(C0[0],C0[1],C1[0]),b=MX3(C0[2],C0[3],C1[1]); a=MX3(a,C1[2],C1[3]); \
      _Pragma("unroll") for(int r=4;r<16;r+=4){a=MX3(a,C0[r],C0[r+1]);b=MX3(b,C0[r+2],C0[r+3]);a=MX3(a,C1[r],C1[r+1]);b=MX3(b,C1[r+2],C1[r+3]);} \
      float rm=__builtin_fmaxf(a,b); { auto rr=__builtin_amdgcn_permlane32_swap(__float_as_uint(rm),__float_as_uint(rm),false,false); rm=__builtin_fmaxf(__uint_as_float(rr[0]),__uint_as_float(rr[1])); } \
      resc=false; \
      if(__builtin_expect(__any(rm>(float)THRL),0)){ const float dl=__builtin_fmaxf(rm,0.f); mhat+=dl; \
        _Pragma("unroll") for(int r=0;r<16;++r){C0[r]-=dl;C1[r]-=dl;} \
        _Pragma("unroll") for(int r=0;r<16;++r)negm[r]=-mhat; asm volatile("":"+v"(negm)); \
        const float f=__builtin_amdgcn_exp2f(-dl); l_reg*=f; if(hi==0)wsf[r32]=f; resc=true; } } \
    SBAR(); \
    GAPB2(o[0]=__builtin_amdgcn_mfma_f32_32x32x16_bf16(PAF(0),VFR(0),o[0],0,0,0), C0,0); \
    GAPB2(o[1]=__builtin_amdgcn_mfma_f32_32x32x16_bf16(PAF(0),VFR(4),o[1],0,0,0), C0,2); VRD2(0); VRD2(4); \
    KRD(GL,0); GAPB2(o[0]=__builtin_amdgcn_mfma_f32_32x32x16_bf16(PAF(1),VFR(1),o[0],0,0,0), C0,4); \
    KRD(GL,1); GAPB2(o[1]=__builtin_amdgcn_mfma_f32_32x32x16_bf16(PAF(1),VFR(5),o[1],0,0,0), C0,6); VRD2(1); VRD2(5); \
    GAPB2(o[2]=__builtin_amdgcn_mfma_f32_32x32x16_bf16(PAF(0),VFR(0),o[2],0,0,0), C0,8); \
    GAPB2(o[3]=__builtin_amdgcn_mfma_f32_32x32x16_bf16(PAF(0),VFR(4),o[3],0,0,0), C0,10); \
    KRD(GL,2); GAPB2(o[0]=__builtin_amdgcn_mfma_f32_32x32x16_bf16(PAF(2),VFR(2),o[0],0,0,0), C0,12); \
    KRD(GL,3); GAPB2(o[1]=__builtin_amdgcn_mfma_f32_32x32x16_bf16(PAF(2),VFR(6),o[1],0,0,0), C0,14); VRD2(2); VRD2(6); \
    GAPB2(o[2]=__builtin_amdgcn_mfma_f32_32x32x16_bf16(PAF(1),VFR(1),o[2],0,0,0), C1,0); \
    GAPB2(o[3]=__builtin_amdgcn_mfma_f32_32x32x16_bf16(PAF(1),VFR(5),o[3],0,0,0), C1,2); \
    GAPB2(o[0]=__builtin_amdgcn_mfma_f32_32x32x16_bf16(PAF(3),VFR(3),o[0],0,0,0), C1,4); \
    GAPB2(o[1]=__builtin_amdgcn_mfma_f32_32x32x16_bf16(PAF(3),VFR(7),o[1],0,0,0), C1,6); VRD2(3); VRD2(7); \
    GAPB2(o[2]=__builtin_amdgcn_mfma_f32_32x32x16_bf16(PAF(2),VFR(2),o[2],0,0,0), C1,8); \
    GAPB2(o[3]=__builtin_amdgcn_mfma_f32_32x32x16_bf16(PAF(2),VFR(6),o[3],0,0,0), C1,10); \
    GAPB2(o[2]=__builtin_amdgcn_mfma_f32_32x32x16_bf16(PAF(3),VFR(3),o[2],0,0,0), C1,12); \
    GAPB2(o[3]=__builtin_amdgcn_mfma_f32_32x32x16_bf16(PAF(3),VFR(7),o[3],0,0,0), C1,14); \
    }while(0)
  int t=1;
  #undef CMASK
  #define CMASK(P0,P1,t) do{}while(0)
  for(;t+5<NT;t+=2){
    STEP(pB0,pB1,pA0,pA1,t,true,true,true);     WAIT_BAR(3); RESC(); ROT();
    STEP(pA0,pA1,pB0,pB1,t+1,true,true,true);   WAIT_BAR(3); RESC(); ROT();
  }
  #undef CMASK
  #define CMASK(P0,P1,t) do{int jb_=(t)-(NT-4); if(jb_>=0)cmask(P0,P1,jb_,qrel,hi);}while(0)
  #define ENDW(tt) do{ if((tt)+3<NT){WAIT_BAR(3);} else if((tt)+2<NT){WAIT_BAR(2);} else {WAIT_BAR(0);} }while(0)
  for(;t+1<NT;t+=2){
    STEP(pB0,pB1,pA0,pA1,t,(t+3<NT),(t+1<NT),(t+1<NT));       ENDW(t);   RESC(); ROT();
    STEP(pA0,pA1,pB0,pB1,t+1,(t+4<NT),(t+2<NT),(t+2<NT));     ENDW(t+1); RESC(); ROT();
  }
  STEP(pB0,pB1,pA0,pA1,NT-1,false,false,false); RESC();
  { float sacc=pB0[0]+pB0[1]; _Pragma("unroll") for(int r=2;r<16;++r)sacc+=pB0[r]; _Pragma("unroll") for(int r=0;r<16;++r)sacc+=pB1[r]; l_reg+=sacc;
    pw0=(u32x4){PKW(pB0,0),PKW(pB0,2),PKW(pB0,4),PKW(pB0,6)};pw1=(u32x4){PKW(pB0,8),PKW(pB0,10),PKW(pB0,12),PKW(pB0,14)};pw2=(u32x4){PKW(pB1,0),PKW(pB1,2),PKW(pB1,4),PKW(pB1,6)};pw3=(u32x4){PKW(pB1,8),PKW(pB1,10),PKW(pB1,12),PKW(pB1,14)};
    SBAR(); pv(o,vb0+2*sl_cur,PAF(0),PAF(1),PAF(2),PAF(3)); pv(o+2,vb0+2*sl_cur+8192,PAF(0),PAF(1),PAF(2),PAF(3)); }
  #undef PKW
  #undef PAF
  #undef VFR
  #undef PIN
  #undef MX3
  #undef GAPA
  #undef GAPB
  #undef EX
  #undef VRD
  #undef KRD
  #undef STEP
  #undef ENDW
  {auto rr=__builtin_amdgcn_permlane32_swap(__float_as_uint(l_reg),__float_as_uint(l_reg),false,false);l_reg=__uint_as_float(rr[0])+__uint_as_float(rr[1]);}
  if(hi==0)wsf[32+r32]=l_reg;asm volatile("s_waitcnt lgkmcnt(0)":::"memory");
  float rli[16];
  #pragma unroll
  for(int r=0;r<16;++r)rli[r]=__builtin_amdgcn_rcpf(wsf[32+crow(r,hi)]);
  bf16*Ow=O+(long)(q0+wid*QBLK)*PO;
  { bf16*stg=(bf16*)(shm+LDS_OST)+wid*2048;
    #pragma unroll
    for(int hf=0;hf<2;++hf){
      #pragma unroll
      for(int r=0;r<16;++r){const int orow=crow(r,hi);
        #pragma unroll
        for(int d0=0;d0<2;++d0)stg[orow*64+d0*32+r32]=__float2bfloat16(o[2*hf+d0][r]*rli[r]);}
      asm volatile("s_waitcnt lgkmcnt(0)":::"memory");
      #pragma unroll
      for(int i=0;i<4;++i){const int row=i*8+(lane>>3),ch=lane&7; const u32x4 v=*(const u32x4*)(stg+row*64+ch*8); if(q0+wid*QBLK+row<lvalid)ATTN_STORE16(Ow+(long)row*PO+hf*64+ch*8,v);}
      asm volatile("s_waitcnt lgkmcnt(0)":::"memory");
    } }
  asm volatile("s_waitcnt lgkmcnt(0)\n\ts_barrier":::"memory");
  #undef DMA_K
  #undef DMA_V
  #undef CMASK
  #undef START
  #undef RESC
  #undef ROT
}
constexpr int ATTN_LDS_BYTES=LDS_BYTES;
__device__ __forceinline__ int deal_qb(int s,int i){ return (i==0)?32-s:(i==1)?17+s:(i==2)?16-s:(i==3)?1+s:0; }
template<int THRL=8> __device__ __forceinline__ void attn_phase(char*lds,const bf16*QKV,bf16*O,int vcu,int G,int L){
  const int s=vcu&7,n=(s==0)?5:4;
  for(int i=0;;++i){
    int c,qb;
    if(G==256){ if(i>=n)break; c=vcu>>3; qb=deal_qb(s,i); }
    else { const int j=vcu+i*G; if(j>=32*33)break; c=j/33; qb=32-(j%33); }
    const int b=c>>4,vh=c&15,m=vh>>3,h=vh&7;
    const bf16*base=QKV+(long)b*L*PQ; bf16*Ob=O+(long)b*L*PO+m*1024+h*128;
    attn_unit<THRL>(qb,L,base+h*128+m*64,base+1024+h*128+m*64,base+2048+h*128,Ob,lds);
  }
}
#undef SBAR
#undef WAIT_BAR
}

#ifndef PG8_ALIGN
#define PG8_ALIGN true
#endif
constexpr int NWAVES = 8;
#ifndef MK_PH
#define MK_PH 0xffffu
#endif
constexpr unsigned PH = MK_PH;
constexpr size_t MiB = 1u << 20;
constexpr size_t W_IN_T = 1 * MiB;
constexpr size_t W_BR_T = W_IN_T + (size_t)INC * DMODEL * 2;
constexpr size_t W_PW_T = W_BR_T + (size_t)3 * 2048 * 1024 * 2;
constexpr size_t W_O_T  = W_PW_T + (size_t)1024 * 256 * 2;
constexpr size_t W_F1_T = W_O_T + (size_t)2048 * 2048 * 2;
constexpr size_t W_F2_T = W_F1_T + (size_t)DFF * DMODEL * 2;
constexpr size_t WS_H   = W_F2_T + (size_t)DFF * DMODEL * 2;
constexpr size_t WS_V = WS_H;
constexpr size_t WS_OM = WS_H + (size_t)MP * DMODEL * 2;
constexpr size_t WS_HN  = WS_H + (size_t)MP * DMODEL * 4;
constexpr size_t WS_QKV = WS_HN + (size_t)MP * DMODEL * 2;
constexpr size_t WS_U4  = WS_QKV + (size_t)MPA * 3072 * 2;
constexpr size_t WS_G   = WS_U4 + (size_t)4 * MP * 1024 * 2;
constexpr size_t WS_END = WS_G + (size_t)MP * 6144 * 2;
constexpr size_t WS_T8 = WS_END;
constexpr size_t WS_T5 = WS_T8 + (size_t)DEPTH * 32 * DFF * 4;
constexpr size_t WS_HT = WS_T5 + (size_t)DEPTH * 32 * DMODEL * 4;
constexpr size_t WS_TEND = WS_HT + (size_t)32 * DMODEL * 4;
constexpr size_t WS_HID = WS_QKV;
static_assert(WS_HID + (size_t)MP * DFF * 2 <= WS_END, "d_ws map");
constexpr int RING_BYTES = 131072, LDS_TOTAL = 147456;
static_assert(pg8::STAGE_BYTES <= RING_BYTES && attn_body::ATTN_LDS_BYTES <= RING_BYTES, "LDS map");

#define GAS __attribute__((address_space(1)))
#define LAS __attribute__((address_space(3)))
typedef unsigned short bf16u;
typedef unsigned v4u __attribute__((ext_vector_type(4)));
typedef unsigned v2u __attribute__((ext_vector_type(2)));
typedef float f32x4 __attribute__((ext_vector_type(4)));
#define LDS_WAIT() asm volatile("s_waitcnt lgkmcnt(0)" ::: "memory")
__device__ __forceinline__ unsigned pk2(float lo, float hi) { return pg8::cvt_pk_bf16(lo, hi); }
__device__ __forceinline__ float wave_sum(float v) {
#pragma unroll
    for (int o = 1; o < 64; o <<= 1) v += __shfl_xor(v, o);
    return v;
}
typedef GAS unsigned gu32;
#define XB_TMO      128
#define XB_XCNT(j)  (256  + 64 * (j))
#define XB_XSUB(j)  (1280 + 64 * (j))
#define XB_XGEN(j)  (2304 + 64 * (j))
#define XB_TOP      3328
#define XB_TOPGEN   3392
#define XCD_BAR_WORDS 3456
#define XB_SPIN_CAP (1u << 18)

__device__ __forceinline__ unsigned xb_ld(unsigned* p)              { return __hip_atomic_load(p, __ATOMIC_RELAXED, __HIP_MEMORY_SCOPE_AGENT); }
__device__ __forceinline__ unsigned xb_add(unsigned* p, unsigned v) { return __hip_atomic_fetch_add(p, v, __ATOMIC_RELAXED, __HIP_MEMORY_SCOPE_AGENT); }
__device__ __forceinline__ unsigned xb_xcc_id() { return (unsigned)__builtin_amdgcn_s_getreg((3 << 11) | 20) & 0xFu; }
#define XB_SPIN(cond, bar) do { unsigned _sp = 0; while (cond) { __builtin_amdgcn_s_sleep(1); \
    if ((++_sp & 255u) == 0u) { if (xb_ld(&(bar)[XB_TMO])) break; if (_sp > XB_SPIN_CAP) { atomicAdd(&(bar)[XB_TMO], 1u); break; } } } } while (0)

struct XcdBarrier {
    unsigned* bar; unsigned x;
    volatile LAS unsigned* st;
};

__device__ __forceinline__ XcdBarrier xcd_barrier_post(unsigned* bar, volatile LAS unsigned* st) {
    XcdBarrier b; b.bar = bar; b.x = xb_xcc_id(); b.st = st;
    if (threadIdx.x == 0) (void)xb_add(&bar[XB_XCNT(b.x)], 1u);
    return b;
}
__device__ __forceinline__ void xcd_barrier_complete(unsigned* bar, unsigned x, unsigned& nloc, unsigned& nx) {
    const unsigned G = gridDim.x * gridDim.y * gridDim.z;
    unsigned sum, cnt, mine, sp = 0u;
    for (;;) {
        sum = 0u; cnt = 0u; mine = 0u;
#pragma unroll
        for (unsigned j = 0; j < 16; ++j) { const unsigned c = xb_ld(&bar[XB_XCNT(j)]); sum += c; cnt += (c > 0u) ? 1u : 0u; mine = (j == x) ? c : mine; }
        if (sum == G) break;
        __builtin_amdgcn_s_sleep(1);
        if ((++sp & 255u) == 0u) { if (xb_ld(&bar[XB_TMO])) break; if (sp > XB_SPIN_CAP) { atomicAdd(&bar[XB_TMO], 1u); break; } }
    }
    nloc = mine > 0u ? mine : 1u; nx = cnt > 0u ? cnt : 1u;
}

__device__ __forceinline__ void xcd_barrier(const XcdBarrier& b) {
    asm volatile("s_waitcnt vmcnt(0)" ::: "memory");
    __syncthreads();
    if (threadIdx.x == 0) {
        unsigned* bar = b.bar;
        __builtin_amdgcn_s_waitcnt(0);
        unsigned nloc = b.st[0], nx = b.st[1];
        if (nloc == 0u) { xcd_barrier_complete(bar, b.x, nloc, nx); b.st[0] = nloc; b.st[1] = nx; }
        const unsigned old = xb_add(&bar[XB_XSUB(b.x)], 1u);
        const unsigned gen = old / nloc;
        if (old + 1u == (gen + 1u) * nloc) {
            __builtin_amdgcn_fence(__ATOMIC_RELEASE, "agent");
            asm volatile("s_waitcnt vmcnt(0)" ::: "memory");
            const unsigned og = xb_add(&bar[XB_TOP], 1u);
            const unsigned tg = og / nx;
            if (og + 1u == (tg + 1u) * nx) xb_add(&bar[XB_TOPGEN], 1u);
            else XB_SPIN(xb_ld(&bar[XB_TOPGEN]) == tg, bar);
            __builtin_amdgcn_fence(__ATOMIC_ACQUIRE, "agent");
            xb_add(&bar[XB_XGEN(b.x)], 1u);
            asm volatile("s_waitcnt vmcnt(0)" ::: "memory");
        } else {
            XB_SPIN(xb_ld(&bar[XB_XGEN(b.x)]) == gen, bar);
            __builtin_amdgcn_fence(__ATOMIC_ACQUIRE, "agent");
            asm volatile("s_waitcnt vmcnt(0)" ::: "memory");
        }
    }
    __syncthreads();
}

struct Args { const float* in[24]; float* out; unsigned char* ws; };
__device__ __forceinline__ const void* argp(int i) { const __attribute__((address_space(4))) char* k = (const __attribute__((address_space(4))) char*)__builtin_amdgcn_kernarg_segment_ptr(); asm volatile("" : "+s"(k)); return *(const void* const __attribute__((address_space(4)))*)(k + 8 * i); }
#define IN(i) ((const float*)(const GAS float*)argp(i))
#define OUTP() ((float*)(GAS float*)argp(24))
#define WSP() ((unsigned char*)(GAS unsigned char*)argp(25))

__device__ __forceinline__ void transpose_item(const float* W, int K, int N, bf16u* WT, int ldwt, LAS float* scr, int item, int lane) {
    const int nblk = N / 32, kb = item / nblk, nb = item - kb * nblk, k0 = 64 * kb, n0 = 32 * nb;
    const float* src = W + (size_t)(k0 + (lane >> 5)) * N + n0 + (lane & 31);
#pragma unroll
    for (int i = 0; i < 32; ++i) scr[(2 * i + (lane >> 5)) * 33 + (lane & 31)] = __builtin_nontemporal_load(src + (size_t)(2 * i) * N);
    LDS_WAIT(); asm volatile("" ::: "memory");
    const int c = lane & 7;
#pragma unroll
    for (int j = 0; j < 4; ++j) { const int n = (lane >> 3) + 8 * j; const LAS float* s = scr + (8 * c) * 33 + n;
        v4u o; o.x = pk2(s[0 * 33], s[1 * 33]); o.y = pk2(s[2 * 33], s[3 * 33]); o.z = pk2(s[4 * 33], s[5 * 33]); o.w = pk2(s[6 * 33], s[7 * 33]);
        *(v4u*)(WT + (size_t)(n0 + n) * ldwt + k0 + 8 * c) = o; }
    LDS_WAIT(); asm volatile("" ::: "memory");
}
__device__ __forceinline__ void convert_weights(int l, LAS unsigned char* lds, int gw, int NGW, int wave, int lane) {
    LAS float* scr = (LAS float*)(lds + wave * 16384);
    constexpr int I_IN = 32 * 416, I_BR = 16 * 64, I_PW = 16, I_O = 32 * 64, I_F1 = 32 * 256, I_F2 = 128 * 64;
    constexpr int NITEMS = I_IN + 3 * I_BR + 4 * I_PW + I_O + I_F1 + I_F2;
    unsigned char* ws = WSP();
    for (int it = gw; it < NITEMS; it += NGW) {
        int r = it; const float* W; int K, N, ldwt = 0; bf16u* WT;
        if (r < I_IN) { W = IN(4) + (size_t)l * 2048 * INC; K = 2048; N = INC; WT = (bf16u*)(ws + W_IN_T); }
        else if ((r -= I_IN) < 3 * I_BR) { const int i = r / I_BR; r -= i * I_BR; W = (i == 0 ? IN(11) : i == 1 ? IN(14) : IN(16)) + (size_t)l * 1024 * 2048; K = 1024; N = 2048; WT = (bf16u*)(ws + W_BR_T) + (size_t)i * 1024; ldwt = 3072; }
        else if ((r -= 3 * I_BR) < 4 * I_PW) { const int g = r / I_PW; r -= g * I_PW;
            const float* src = IN(12) + (size_t)(l * 4 + g) * 65536 + (size_t)r * 4096 + lane * 4; const f32x4 sc = *(const f32x4*)(IN(13) + (size_t)l * 1024 + g * 256 + lane * 4);
            bf16u* dst = (bf16u*)(ws + W_PW_T) + (size_t)g * 65536 + (size_t)r * 4096 + lane * 4;
#pragma unroll
            for (int q = 0; q < 16; ++q) { const f32x4 v = *(const f32x4*)(src + q * 256) * sc; *(v2u*)(dst + q * 256) = (v2u){pk2(v.x, v.y), pk2(v.z, v.w)}; }
            continue; }
        else if ((r -= 4 * I_PW) < I_O) { W = IN(17) + (size_t)l * 2048 * 2048; K = 2048; N = 2048; WT = (bf16u*)(ws + W_O_T); }
        else if ((r -= I_O) < I_F1) { W = IN(20) + (size_t)l * 2048 * DFF; K = 2048; N = DFF; WT = (bf16u*)(ws + W_F1_T); }
        else { r -= I_F1; W = IN(21) + (size_t)l * DFF * 2048; K = DFF; N = 2048; WT = (bf16u*)(ws + W_F2_T); }
        transpose_item(W, K, N, WT, ldwt ? ldwt : K, scr, r, lane);
    }
}
template <int MODE>
__device__ __forceinline__ void ln_load(f32x4 (&v)[8], int m, int lane) {
    if (MODE == 0) { const int b = m >= LSEQ ? 1 : 0, p = m - b * LSEQ; const float* src = p < NMETA ? IN(1) + (size_t)p * DMODEL : IN(0) + ((size_t)b * SEQ + (p - NMETA)) * DMODEL;
#pragma unroll
        for (int j = 0; j < 8; ++j) v[j] = __builtin_nontemporal_load((const f32x4*)src + lane + 64 * j);
    } else if (m >= TAIL0) { const float* src = (const float*)(WSP() + WS_HT) + (size_t)(m - TAIL0) * DMODEL;
#pragma unroll
        for (int j = 0; j < 8; ++j) v[j] = ((const f32x4*)src)[lane + 64 * j];
    } else { const bf16u* src = (const bf16u*)(WSP() + WS_V) + (size_t)m * DMODEL;
#pragma unroll
        for (int j = 0; j < 8; ++j) { const v2u w = ((const v2u*)src)[lane + 64 * j]; v[j] = (f32x4){pg8::bf_lo(w.x), pg8::bf_hi(w.x), pg8::bf_lo(w.y), pg8::bf_hi(w.y)}; } }
}
template <int MODE>
__device__ __forceinline__ void ln_pass(const float* gam, const float* bet, int gw, int NGW, int lane) {
    bf16u* hn = (bf16u*)(WSP() + WS_HN); float* ht = (float*)(WSP() + WS_HT);
    if (MODE != 2) for (int m = MROWS + gw; m < MP; m += NGW) {
#pragma unroll
        for (int j = 0; j < 8; ++j) ((v2u*)(hn + (size_t)m * DMODEL))[lane + 64 * j] = (v2u){0u, 0u}; }
    f32x4 g4[8], b4[8];
#pragma unroll
    for (int j = 0; j < 8; ++j) { g4[j] = ((const f32x4*)gam)[lane + 64 * j]; b4[j] = ((const f32x4*)bet)[lane + 64 * j]; }
    f32x4 v[8], vn[8];
    int m = gw;
    if (m < MROWS) ln_load<MODE>(v, m, lane);
    while (m < MROWS) {
        const int mn = m + NGW;
        if (mn < MROWS) ln_load<MODE>(vn, mn, lane);
        const int b = m >= LSEQ ? 1 : 0, p = m - b * LSEQ;
        float s = 0.f;
#pragma unroll
        for (int j = 0; j < 8; ++j) s += (v[j].x + v[j].y) + (v[j].z + v[j].w);
        const float mean = wave_sum(s) * (1.f / DMODEL); float s2 = 0.f;
#pragma unroll
        for (int j = 0; j < 8; ++j) { v[j] = v[j] - mean; s2 += (v[j].x * v[j].x + v[j].y * v[j].y) + (v[j].z * v[j].z + v[j].w * v[j].w); }
        const float rstd = 1.f / sqrtf(wave_sum(s2) * (1.f / DMODEL) + LN_EPS);
#pragma unroll
        for (int j = 0; j < 8; ++j) {
            const f32x4 y = v[j] * rstd * g4[j] + b4[j];
            if (MODE != 2) {
                if (m >= TAIL0) ((f32x4*)(ht + (size_t)(m - TAIL0) * DMODEL))[lane + 64 * j] = y * DN_ALPHA;
                ((v2u*)(hn + (size_t)m * DMODEL))[lane + 64 * j] = (v2u){pk2(y.x, y.y), pk2(y.z, y.w)};
            } else if (p >= NMETA) __builtin_nontemporal_store(y, (f32x4*)(OUTP() + ((size_t)b * SEQ + (p - NMETA)) * DMODEL) + lane + 64 * j);
        }
#pragma unroll
        for (int j = 0; j < 8; ++j) v[j] = vn[j];
        m = mn;
    }
}
__device__ __forceinline__ void unpack8(const v4u w, float* f) {
    f[0] = pg8::bf_lo(w.x); f[1] = pg8::bf_hi(w.x); f[2] = pg8::bf_lo(w.y); f[3] = pg8::bf_hi(w.y); f[4] = pg8::bf_lo(w.z); f[5] = pg8::bf_hi(w.z); f[6] = pg8::bf_lo(w.w); f[7] = pg8::bf_hi(w.w);
}
__device__ __forceinline__ v4u pack8f(const float* f) { v4u o; o.x = pk2(f[0], f[1]); o.y = pk2(f[2], f[3]); o.z = pk2(f[4], f[5]); o.w = pk2(f[6], f[7]); return o; }
__device__ __forceinline__ v4u sel4(bool c, const v4u a, const v4u b) { v4u r; r.x = c ? a.x : b.x; r.y = c ? a.y : b.y; r.z = c ? a.z : b.z; r.w = c ? a.w : b.w; return r; }
__device__ __forceinline__ void pool_block(const bf16u* up, bf16u* yp, int p0, int w) {
    v4u x[23];
#pragma unroll
    for (int k = 0; k < 23; ++k) { x[k] = (v4u){0u, 0u, 0u, 0u}; if (k >= 16 - w && p0 + k - 15 >= 0) x[k] = *(const v4u*)(up + ((long)k - 15) * 1024); }
    float S[8];
#pragma unroll
    for (int c = 0; c < 8; ++c) S[c] = 0.f;
#pragma unroll
    for (int k = 0; k < 15; ++k) { float f8[8]; unpack8(x[k], f8);
#pragma unroll
        for (int c = 0; c < 8; ++c) S[c] += f8[c]; }
#pragma unroll
    for (int i = 0; i < 8; ++i) { float cur[8], old[8], o8[8]; unpack8(x[15 + i], cur);
        const v4u xo = sel4(w == 16, x[i], sel4(w == 8, x[i + 8], sel4(w == 4, x[i + 12], x[i + 14])));
        unpack8(xo, old);
        const int p = p0 + i; const float inv = 1.0f / (float)((p + 1 < w) ? p + 1 : w);
#pragma unroll
        for (int c = 0; c < 8; ++c) { S[c] += cur[c]; o8[c] = S[c] * inv - cur[c]; S[c] -= old[c]; }
        *(v4u*)(yp + (size_t)i * 3072) = pack8f(o8); }
}
__device__ __forceinline__ void elementwise_phase(int l, int gw, int NGW, int lane) {
    unsigned char* ws = WSP();
    const float lam_init = (l == 0) ? 0.2f : 0.3555090676f;
    const float lam = expf(wave_sum(IN(6)[l * 64 + lane] * IN(7)[l * 64 + lane])) - expf(wave_sum(IN(8)[l * 64 + lane] * IN(9)[l * 64 + lane])) + lam_init;
    const bf16u* O = (const bf16u*)(ws + WS_OM); bf16u* Y = (bf16u*)(ws + WS_QKV);
    const bf16u* UP = (const bf16u*)(ws + WS_U4); const bf16u* UC = UP + (size_t)MP * 1024; const bf16u* GB = UC + (size_t)MP * 1024; const bf16u* GC = GB + (size_t)MP * 1024;
    {
        const int hh = lane >> 3, off = (lane & 7) * 16; const float osc = 1.0f - lam_init;
        float gs[16];
#pragma unroll
        for (int k = 0; k < 16; ++k) gs[k] = IN(10)[l * 128 + off + k] * osc;
        for (int m0 = gw; m0 < MROWS; m0 += 2 * NGW) {
            v4u q[2][4];
#pragma unroll
            for (int r = 0; r < 2; ++r) { const int m = m0 + r * NGW; if (m < MROWS) { const bf16u* orow = O + (size_t)m * 2048 + hh * 128 + off;
                q[r][0] = *(const v4u*)orow; q[r][1] = *(const v4u*)(orow + 8); q[r][2] = *(const v4u*)(orow + 1024); q[r][3] = *(const v4u*)(orow + 1032); } }
#pragma unroll
            for (int r = 0; r < 2; ++r) { const int m = m0 + r * NGW; if (m < MROWS) {
                float o1[16], o2[16];
                unpack8(q[r][0], o1); unpack8(q[r][1], o1 + 8); unpack8(q[r][2], o2); unpack8(q[r][3], o2 + 8);
                float ss = 0.f;
#pragma unroll
                for (int k = 0; k < 16; ++k) { o1[k] = o1[k] - lam * o2[k]; ss += o1[k] * o1[k]; }
                ss += __shfl_xor(ss, 1); ss += __shfl_xor(ss, 2); ss += __shfl_xor(ss, 4);
                const float rstd = 1.f / sqrtf(ss * (1.f / 128.f) + RMS_EPS);
#pragma unroll
                for (int k = 0; k < 16; ++k) o1[k] = o1[k] * rstd * gs[k];
                bf16u* yrow = Y + (size_t)m * 3072 + hh * 128 + off;
                *(v4u*)yrow = pack8f(o1); *(v4u*)(yrow + 8) = pack8f(o1 + 8); } }
        }
    }
    {
        for (int it = gw; it < (MROWS / 16) * 4; it += NGW) {
            const int g = it & 3, row0 = 16 * (it >> 2) + 8 * (lane >> 5); const int b = row0 >= LSEQ ? 1 : 0, p0 = row0 - b * LSEQ;
            const bf16u* up = UP + (size_t)row0 * 1024 + g * 256 + (lane & 31) * 8; bf16u* yp = Y + (size_t)row0 * 3072 + 1024 + g * 256 + (lane & 31) * 8;
            pool_block(up, yp, p0, 2 << g);
        }
    }
    {
        const int c0 = lane * 16;
        float cw[3][16];
#pragma unroll
        for (int j = 0; j < 3; ++j)
#pragma unroll
            for (int k = 0; k < 16; ++k) cw[j][k] = IN(15)[(size_t)l * 3072 + j * 1024 + c0 + k];
        for (int m0 = gw; m0 < MROWS; m0 += 2 * NGW) {
            v4u qu[2][3][2], qg[2][3][2], qb[2][2]; int pp[2];
#pragma unroll
            for (int r = 0; r < 2; ++r) { const int m = m0 + r * NGW; if (m < MROWS) { const int b = m >= LSEQ ? 1 : 0; pp[r] = m - b * LSEQ;
#pragma unroll
                for (int j = 0; j < 3; ++j) if (pp[r] - 2 + j >= 0) { const size_t ro = (size_t)(m - 2 + j) * 1024 + c0;
                    qu[r][j][0] = *(const v4u*)(UC + ro); qu[r][j][1] = *(const v4u*)(UC + ro + 8); qg[r][j][0] = *(const v4u*)(GC + ro); qg[r][j][1] = *(const v4u*)(GC + ro + 8); }
                const size_t ro = (size_t)m * 1024 + c0; qb[r][0] = *(const v4u*)(GB + ro); qb[r][1] = *(const v4u*)(GB + ro + 8); } }
#pragma unroll
            for (int r = 0; r < 2; ++r) { const int m = m0 + r * NGW; if (m < MROWS) {
                float acc[16];
#pragma unroll
                for (int k = 0; k < 16; ++k) acc[k] = 0.f;
#pragma unroll
                for (int j = 0; j < 3; ++j) if (pp[r] - 2 + j >= 0) { float u[16], gc[16];
                    unpack8(qu[r][j][0], u); unpack8(qu[r][j][1], u + 8); unpack8(qg[r][j][0], gc); unpack8(qg[r][j][1], gc + 8);
#pragma unroll
                    for (int k = 0; k < 16; ++k) acc[k] += cw[j][k] * (gc[k] * u[k]); }
                float gb[16]; unpack8(qb[r][0], gb); unpack8(qb[r][1], gb + 8);
#pragma unroll
                for (int k = 0; k < 16; ++k) acc[k] *= gb[k];
                bf16u* yrow = Y + (size_t)m * 3072 + 2048 + c0;
                *(v4u*)yrow = pack8f(acc); *(v4u*)(yrow + 8) = pack8f(acc + 8); } }
        }
    }
}

__device__ __forceinline__ int opaque_v(int x) { asm volatile("" : "+v"(x)); return x; }
__device__ __forceinline__ int opaque_s(int x) { asm volatile("" : "+s"(x)); return x; }
typedef short bf16x8_t __attribute__((ext_vector_type(8)));
typedef float f32x16_t __attribute__((ext_vector_type(16)));
__device__ __forceinline__ void inproj_tail(int l, LAS unsigned char* lds, int bx, int G, int tid) {
    const int lane = tid & 63, w = __builtin_amdgcn_readfirstlane(tid >> 6), r32 = lane & 31, hi = lane >> 5;
    unsigned char* ws = WSP();
    const bf16u* HNp = (const bf16u*)(ws + WS_HN); const bf16u* W = (const bf16u*)(ws + W_IN_T);
    bf16u* QKVp = (bf16u*)(ws + WS_QKV); bf16u* U4p = (bf16u*)(ws + WS_U4); bf16u* Gp = (bf16u*)(ws + WS_G); const float* bgate = IN(5) + (size_t)l * 6144;
    LAS float* P = (LAS float*)lds;
    for (int cb = bx; cb < 256; cb += G) {
        const int n0 = cb * 52;
        const bf16u* A = HNp + (size_t)(TAIL0 + r32) * DMODEL + w * 256 + 8 * hi;
        const bf16u* B0 = W + (size_t)(n0 + r32) * DMODEL + w * 256 + 8 * hi; const bf16u* B1 = B0 + (size_t)32 * DMODEL;
        f32x16_t acc0 = {}, acc1 = {};
#pragma unroll 8
        for (int s = 0; s < 16; ++s) { const bf16x8_t a = *(const bf16x8_t*)(A + 16 * s), b0 = *(const bf16x8_t*)(B0 + 16 * s), b1 = *(const bf16x8_t*)(B1 + 16 * s);
            acc0 = __builtin_amdgcn_mfma_f32_32x32x16_bf16(b0, a, acc0, 0, 0, 0); acc1 = __builtin_amdgcn_mfma_f32_32x32x16_bf16(b1, a, acc1, 0, 0, 0); }
#pragma unroll
        for (int r = 0; r < 16; ++r) { P[((w * 2 + 0) * 16 + r) * 64 + lane] = acc0[r]; P[((w * 2 + 1) * 16 + r) * 64 + lane] = acc1[r]; }
        __syncthreads();
#pragma unroll
        for (int q = 0; q < 4; ++q) { const int idx = tid + 512 * q, ct = idx >> 10, r = (idx >> 6) & 15, L = idx & 63;
            float v = 0.f;
#pragma unroll
            for (int ww = 0; ww < 8; ++ww) v += P[((ww * 2 + ct) * 16 + r) * 64 + L];
            const int j = L & 31, n = n0 + 32 * ct + (r & 3) + 8 * (r >> 2) + 4 * (L >> 5);
            if (n < n0 + 52) { const int t = n >> 10; const size_t row = (size_t)(TAIL0 + j);
                if (t < 3) QKVp[row * 3072 + n] = (bf16u)(pk2(t == 0 ? v * attn_body::C2 : v, 0.f) & 0xffffu);
                else if (t < 7) U4p[(size_t)(t - 3) * MP * 1024 + row * 1024 + (n & 1023)] = (bf16u)(pk2(v, 0.f) & 0xffffu);
                else Gp[row * 6144 + (n - 7168)] = (bf16u)(pk2(pg8::sigmoid_f(v + bgate[n - 7168]), 0.f) & 0xffffu); }
        }
        __syncthreads();
    }
}
#ifndef MK_DUMP
#define MK_DUMP 0
#endif
#ifndef MK_DUMPL
#define MK_DUMPL 0
#endif
#ifndef MK_DUMPCOL
#define MK_DUMPCOL 0
#endif
__device__ __forceinline__ void dump_bf16(const bf16u* buf, int pitch, int coloff, int gw, int NGW, int lane) {
    float* out = OUTP();
    for (int r = gw; r < BATCH * SEQ; r += NGW) { const int b = r / SEQ, t = r - b * SEQ; const bf16u* src = buf + (size_t)(b * LSEQ + NMETA + t) * pitch + coloff;
#pragma unroll
        for (int j = 0; j < 4; ++j) { float f[8]; unpack8(*(const v4u*)(src + (lane + 64 * j) * 8), f); float* o = out + (size_t)r * DMODEL + (lane + 64 * j) * 8;
            *(f32x4*)o = (f32x4){f[0], f[1], f[2], f[3]}; *(f32x4*)(o + 4) = (f32x4){f[4], f[5], f[6], f[7]}; } }
}
#define PHASE_VARS \
    const int tid = opaque_v((int)threadIdx.x), lane = tid & 63, wave = __builtin_amdgcn_readfirstlane(tid >> 6); \
    const int G = opaque_s((int)gridDim.x), bx = opaque_s((int)blockIdx.x); const int vcu = (G % 8 == 0) ? (bx % 8) * (G / 8) + bx / 8 : bx; \
    const int gw = vcu * NWAVES + wave, NGW = G * NWAVES; unsigned char* ws = WSP(); LAS unsigned char* ldsp = (LAS unsigned char*)lds; \
    pg8::bf16_t* HN = (pg8::bf16_t*)(ws + WS_HN); pg8::bf16_t* QKV = (pg8::bf16_t*)(ws + WS_QKV); pg8::bf16_t* U4 = (pg8::bf16_t*)(ws + WS_U4); pg8::bf16_t* GT = (pg8::bf16_t*)(ws + WS_G); \
    pg8::bf16_t* HID = (pg8::bf16_t*)(ws + WS_HID); pg8::bf16_t* OM = (pg8::bf16_t*)(ws + WS_OM); pg8::bf16_t* VB = (pg8::bf16_t*)(ws + WS_V); float* H = (float*)(ws + WS_HT); (void)OM; (void)VB; \
    (void)tid; (void)lane; (void)wave; (void)vcu; (void)gw; (void)NGW; (void)ldsp; (void)HN; (void)QKV; (void)U4; (void)GT; (void)HID; (void)H;

#define GRID_SYNC() do { XcdBarrier bar_; bar_.bar = (unsigned*)(WSP()) + 4096; bar_.x = xb_xcc_id(); bar_.st = (volatile LAS unsigned*)((LAS unsigned char*)lds + RING_BYTES + 512); xcd_barrier(bar_); } while (0)
__global__ void __launch_bounds__(NWAVES * 64, 2) mega_fwd(Args a) {
    extern __shared__ __attribute__((aligned(16))) unsigned char lds[];
    cg::grid_group grid = cg::this_grid();
    {
        volatile LAS unsigned* st = (volatile LAS unsigned*)((LAS unsigned char*)lds + RING_BYTES + 512);
        if (threadIdx.x < 2) st[threadIdx.x] = 0u;
        if (blockIdx.x == 0) { unsigned* bw = (unsigned*)(WSP()) + 4096; for (int i = threadIdx.x; i < XCD_BAR_WORDS; i += NWAVES * 64) __hip_atomic_store(bw + i, 0u, __ATOMIC_RELAXED, __HIP_MEMORY_SCOPE_AGENT); }
        asm volatile("s_waitcnt vmcnt(0)" ::: "memory");
        __syncthreads();
        grid.sync();
        (void)xcd_barrier_post((unsigned*)(WSP()) + 4096, st);
    }
    {   PHASE_VARS
        for (int i = bx * NWAVES * 64 + tid; i < (MPA - MP) * 3072 * 2 / 16; i += G * NWAVES * 64) ((v4u*)(QKV + (size_t)MP * 3072))[i] = (v4u){0u, 0u, 0u, 0u};
        for (int i = bx * NWAVES * 64 + tid; i < (int)((WS_HT - WS_T8) / 16); i += G * NWAVES * 64) ((v4u*)(ws + WS_T8))[i] = (v4u){0u, 0u, 0u, 0u}; }
#pragma clang loop unroll(disable)
    for (int l = 0; l < DEPTH; ++l) {
        if constexpr (PH & 1u) { PHASE_VARS convert_weights(l, ldsp, gw, NGW, wave, lane); }
        if constexpr (PH & 2u) { PHASE_VARS if (l == 0) ln_pass<0>(IN(2), IN(3), gw, NGW, lane); else ln_pass<1>(IN(22) + (size_t)(l - 1) * DMODEL, IN(23) + (size_t)(l - 1) * DMODEL, gw, NGW, lane); }
        GRID_SYNC();
        if constexpr (PH & 4u) { PHASE_VARS
            pg8::Gemm g{HN, (const pg8::bf16_t*)(ws + W_IN_T), MP, INC, DMODEL, DMODEL, DMODEL, 0u, 0u, 0u, 0u, 0u}; pg8::StaticOrder S; S.init(TAIL0, INC, G, bx);
            pg8::EpiInProj E{QKV, U4, GT, IN(5) + (size_t)l * 6144, attn_body::C2};
            pg8::gemm_phase<pg8::EpiInProj, pg8::StaticOrder, PG8_ALIGN, true>(ldsp, g, S, E);
            inproj_tail(l, ldsp, bx, G, tid);
            {   pg8::Gemm gf{(const pg8::bf16_t*)(ws + W_BR_T) + 1024, (const pg8::bf16_t*)(ws + W_PW_T), DMODEL, 1024, opaque_s(256), 3072, 256, 512u, 0u, 0u, 0u, 0u}; pg8::StaticOrder SF; SF.init(DMODEL, 1024, G, bx);
                pg8::EpiStore EF{(pg8::bf16_t*)(ws + W_BR_T) + 1024, 3072};
                pg8::gemm_phase<pg8::EpiStore, pg8::StaticOrder, PG8_ALIGN, true>(ldsp, gf, SF, EF); } }
        GRID_SYNC();
        if constexpr (MK_DUMP == 1) { if (l == MK_DUMPL) { PHASE_VARS dump_bf16(GT, 6144, MK_DUMPCOL, gw, NGW, lane); return; } }
        if constexpr (MK_DUMP == 4) { if (l == MK_DUMPL) { PHASE_VARS dump_bf16(U4, 1024, MK_DUMPCOL, gw, NGW, lane); return; } }
        if constexpr (PH & 8u) { PHASE_VARS attn_body::attn_phase<8>((char*)lds, (const attn_body::bf16*)QKV, (attn_body::bf16*)OM, vcu, G, LSEQ); }
        GRID_SYNC();
        if constexpr (PH & 16u) { PHASE_VARS elementwise_phase(l, gw, NGW, lane); }
        GRID_SYNC();
        if constexpr (MK_DUMP == 2) { if (l == MK_DUMPL) { PHASE_VARS dump_bf16(QKV, 3072, MK_DUMPCOL, gw, NGW, lane); return; } }
        if constexpr (PH & 64u) { PHASE_VARS
            pg8::Gemm g{QKV, (const pg8::bf16_t*)(ws + W_BR_T), MP, DMODEL, 1024, 3072, 3072, 0u, 2048u, 2048u, 0u, 0u}; pg8::BranchOrder S; S.init(TAIL0, DMODEL, G, bx);
            pg8::EpiBranch E{GT, OM, U4};
            pg8::gemm_phase<pg8::EpiBranch, pg8::BranchOrder, PG8_ALIGN, true>(ldsp, g, S, E);
            pg8::Gemm gt{QKV + (size_t)TAIL0 * 3072, (const pg8::bf16_t*)(ws + W_BR_T), 256, DMODEL, opaque_s(256), 3072, 3072, 0u, 2048u, 2048u, 512u, 512u}; pg8::TailOrder3 T; T.init(G, bx);
            pg8::EpiTailGateAtomic ET{(float*)(ws + WS_T5) + (size_t)l * 32 * DMODEL, GT + (size_t)TAIL0 * 6144};
            pg8::gemm_phase<pg8::EpiTailGateAtomic, pg8::TailOrder3, PG8_ALIGN, true>(ldsp, gt, T, ET); }
        GRID_SYNC();
        if constexpr (MK_DUMP == 3) { if (l == MK_DUMPL) { PHASE_VARS dump_bf16(OM, 2048, 0, gw, NGW, lane); return; } }
        if constexpr (PH & 128u) { PHASE_VARS
            pg8::Gemm g{OM, (const pg8::bf16_t*)(ws + W_O_T), TAIL0, DMODEL, DMODEL, DMODEL, DMODEL, 0u, 0u, 0u, 0u, 0u}; pg8::StaticOrder S; S.init(TAIL0, DMODEL, G, bx);
            pg8::EpiResidV E{VB, HN, DN_ALPHA};
            pg8::gemm_phase<pg8::EpiResidV, pg8::StaticOrder, PG8_ALIGN, true>(ldsp, g, S, E);
            pg8::Gemm gt{OM + (size_t)TAIL0 * DMODEL, (const pg8::bf16_t*)(ws + W_O_T), 256, DMODEL, opaque_s(256), DMODEL, DMODEL, 0u, 512u, 512u, 0u, 0u}; pg8::TailOrder T; T.init(DMODEL / 256, DMODEL / 256, G, bx);
            pg8::EpiTailAtomic ET{H, DMODEL};
            {   pg8::Unit ju; if (T.next(0, ju)) {
                    const int r = tid >> 4, c = ju.br * 256 + (tid & 15) * 16; const float* tp = (const float*)(ws + WS_T5) + (size_t)l * 32 * DMODEL + (size_t)r * DMODEL + c;
                    const f32x4 t0 = *(const f32x4*)tp, t1 = *(const f32x4*)(tp + 4), t2 = *(const f32x4*)(tp + 8), t3 = *(const f32x4*)(tp + 12);
                    pg8::bf16_t* dp = OM + (size_t)(TAIL0 + r) * DMODEL + c; *(v4u*)dp = (v4u){pk2(t0.x, t0.y), pk2(t0.z, t0.w), pk2(t1.x, t1.y), pk2(t1.z, t1.w)}; *(v4u*)(dp + 8) = (v4u){pk2(t2.x, t2.y), pk2(t2.z, t2.w), pk2(t3.x, t3.y), pk2(t3.z, t3.w)}; }
                asm volatile("s_waitcnt vmcnt(0)" ::: "memory"); __syncthreads(); }
            pg8::gemm_phase<pg8::EpiTailAtomic, pg8::TailOrder, PG8_ALIGN, true>(ldsp, gt, T, ET); }
        GRID_SYNC();
        if constexpr (PH & 256u) { PHASE_VARS ln_pass<1>(IN(18) + (size_t)l * DMODEL, IN(19) + (size_t)l * DMODEL, gw, NGW, lane); }
        GRID_SYNC();
        if constexpr (PH & 512u) { PHASE_VARS
            pg8::Gemm g{HN, (const pg8::bf16_t*)(ws + W_F1_T), MP, DFF, DMODEL, DMODEL, DMODEL, 0u, 0u, 0u, 0u, 0u}; pg8::StaticOrder S; S.init(TAIL0, DFF, G, bx);
            pg8::EpiRelu2 E{HID, DFF};
            pg8::gemm_phase<pg8::EpiRelu2, pg8::StaticOrder, PG8_ALIGN, true>(ldsp, g, S, E);
            pg8::Gemm gt{HN + (size_t)TAIL0 * DMODEL, (const pg8::bf16_t*)(ws + W_F1_T), 256, DFF, opaque_s(256), DMODEL, DMODEL, 0u, 512u, 512u, 0u, 0u}; pg8::TailOrder T; T.init(DFF / 256, DMODEL / 256, G, bx);
            pg8::EpiTailAtomic ET{(float*)(ws + WS_T8) + (size_t)l * 32 * DFF, DFF};
            pg8::gemm_phase<pg8::EpiTailAtomic, pg8::TailOrder, PG8_ALIGN, true>(ldsp, gt, T, ET); }
        GRID_SYNC();
        if constexpr (PH & 1024u) { PHASE_VARS
            pg8::Gemm g{HID, (const pg8::bf16_t*)(ws + W_F2_T), TAIL0, DMODEL, DFF, DFF, DFF, 0u, 0u, 0u, 0u, 0u}; pg8::StaticOrder S; S.init(TAIL0, DMODEL, G, bx);
            pg8::EpiResidV E{VB, HN, DN_ALPHA};
            pg8::gemm_phase<pg8::EpiResidV, pg8::StaticOrder, PG8_ALIGN, true>(ldsp, g, S, E);
            pg8::Gemm gt{HID + (size_t)TAIL0 * DFF, (const pg8::bf16_t*)(ws + W_F2_T), 256, DMODEL, opaque_s(256), DFF, DFF, 0u, 512u, 512u, 0u, 0u}; pg8::TailOrder T; T.init(DMODEL / 256, DFF / 256, G, bx);
            pg8::EpiTailAtomic ET{H, DMODEL};
            {   pg8::Unit ju; if (T.next(0, ju)) {
                    const int r = tid >> 4, c = ju.br * 256 + (tid & 15) * 16; const float* tp = (const float*)(ws + WS_T8) + (size_t)l * 32 * DFF + (size_t)r * DFF + c;
                    f32x4 t0 = *(const f32x4*)tp, t1 = *(const f32x4*)(tp + 4), t2 = *(const f32x4*)(tp + 8), t3 = *(const f32x4*)(tp + 12);
#pragma unroll
                    for (int e = 0; e < 4; ++e) { t0[e] = fmaxf(t0[e], 0.f); t0[e] *= t0[e]; t1[e] = fmaxf(t1[e], 0.f); t1[e] *= t1[e]; t2[e] = fmaxf(t2[e], 0.f); t2[e] *= t2[e]; t3[e] = fmaxf(t3[e], 0.f); t3[e] *= t3[e]; }
                    pg8::bf16_t* dp = HID + (size_t)(TAIL0 + r) * DFF + c; *(v4u*)dp = (v4u){pk2(t0.x, t0.y), pk2(t0.z, t0.w), pk2(t1.x, t1.y), pk2(t1.z, t1.w)}; *(v4u*)(dp + 8) = (v4u){pk2(t2.x, t2.y), pk2(t2.z, t2.w), pk2(t3.x, t3.y), pk2(t3.z, t3.w)}; }
                asm volatile("s_waitcnt vmcnt(0)" ::: "memory"); __syncthreads(); }
            pg8::gemm_phase<pg8::EpiTailAtomic, pg8::TailOrder, PG8_ALIGN, true>(ldsp, gt, T, ET); }
        GRID_SYNC();
    }
    if constexpr (PH & 2048u) { PHASE_VARS ln_pass<2>(IN(22) + (size_t)(DEPTH - 1) * DMODEL, IN(23) + (size_t)(DEPTH - 1) * DMODEL, gw, NGW, lane); }
}

extern "C" void kernel_launch(void* const* d_in, const int* in_sizes, int n_in, void* d_out, int out_size, void* d_ws, size_t ws_size, hipStream_t stream) {
    static int grid = 0;
    if (grid == 0) {
        if (n_in != 24 || in_sizes[0] != BATCH * SEQ * DMODEL || out_size != BATCH * SEQ * DMODEL || ws_size < WS_TEND) {
            fprintf(stderr, "kernel_launch: unexpected shapes / workspace (n_in %d, in0 %d, out %d, ws %zu < %zu); nothing launched\n", n_in, n_in > 0 ? in_sizes[0] : -1, out_size, ws_size, (size_t)WS_TEND); grid = -1; return; }
        int dev = 0, cus = 0, per_cu = 0;
        if (hipGetDevice(&dev) != hipSuccess || hipDeviceGetAttribute(&cus, hipDeviceAttributeMultiprocessorCount, dev) != hipSuccess) { grid = -1; return; }
        if (hipFuncSetAttribute((const void*)mega_fwd, hipFuncAttributeMaxDynamicSharedMemorySize, LDS_TOTAL) != hipSuccess) { fprintf(stderr, "kernel_launch: hipFuncSetAttribute failed\n"); grid = -1; return; }
        if (hipOccupancyMaxActiveBlocksPerMultiprocessor(&per_cu, (const void*)mega_fwd, NWAVES * 64, LDS_TOTAL) != hipSuccess || per_cu < 1) per_cu = 1;
        (void)hipGetLastError();
        grid = cus * per_cu;
    }
    if (grid < 0) return;
    Args a{};
    for (int i = 0; i < 24; ++i) a.in[i] = (const float*)d_in[i];
    a.out = (float*)d_out; a.ws = (unsigned char*)d_ws;
    void* args[] = {&a};
    hipError_t e = hipLaunchCooperativeKernel((const void*)mega_fwd, dim3(grid), dim3(NWAVES * 64), args, LDS_TOTAL, stream);
    if (e != hipSuccess) fprintf(stderr, "kernel_launch: cooperative launch failed: %s (grid %d)\n", hipGetErrorString(e), grid);
}
```
